# Optimizing an MI355X kernel written in HIP

```python
import jax
import jax.numpy as jnp
from jax import lax
import numpy as np

D_MODEL = 1024
BATCH = 8
SEQ = 2048
DEPTH = 2

HEAD_DIM = 64
GMLP_GROUPS = 8
GMLP_WIDTH = GMLP_GROUPS * HEAD_DIM
CHUNK = 128
FOX_HEADS = 8
FOX_WIDTH = FOX_HEADS * HEAD_DIM
Q_BLOCK = 128
SWA_Q_HEADS = 8
SWA_KV_HEADS = 2
SWA_GROUP = SWA_Q_HEADS // SWA_KV_HEADS
SWA_WIDTH = SWA_Q_HEADS * HEAD_DIM
KV_WIDTH = SWA_KV_HEADS * HEAD_DIM
WINDOW = 128
CONV_CH = 512
CONV_WIDTH = 31
ROPE_THETA = 500000.0
ROT_DIM = HEAD_DIM // 4
N_GROUPS = 4
EXPERTS_PER_GROUP = 8
N_EXPERTS = N_GROUPS * EXPERTS_PER_GROUP
TOP_K = 2
D_EXPERT = 256
D_PLE = 256
EPS = 1e-6
N_EVEN = (DEPTH + 1) // 2
N_ODD = DEPTH // 2
EVEN_IN = 2 * GMLP_WIDTH + 3 * FOX_WIDTH + FOX_HEADS
EVEN_SPLITS = (2 * GMLP_WIDTH, 2 * GMLP_WIDTH + FOX_WIDTH, 2 * GMLP_WIDTH + 2 * FOX_WIDTH, 2 * GMLP_WIDTH + 3 * FOX_WIDTH)
ODD_IN = SWA_WIDTH + 2 * KV_WIDTH + 2 * CONV_CH
ODD_SPLITS = (SWA_WIDTH, SWA_WIDTH + KV_WIDTH, SWA_WIDTH + 2 * KV_WIDTH)

kernel_name = 'hybrid_gmlp_fox_swa_conformer_hmoe'


def rmsnorm(x, g):
    xf = x.astype(jnp.float32)
    y = xf * lax.rsqrt(jnp.mean(xf * xf, axis=-1, keepdims=True) + EPS)
    return (y * g.astype(jnp.float32)).astype(x.dtype)


def layernorm(x, g, b):
    xf = x.astype(jnp.float32)
    mu = jnp.mean(xf, axis=-1, keepdims=True)
    var = jnp.mean(jnp.square(xf - mu), axis=-1, keepdims=True)
    y = (xf - mu) * lax.rsqrt(var + EPS) * g.astype(jnp.float32) + b.astype(jnp.float32)
    return y.astype(x.dtype)


def partial_rope(x, pos):
    half = ROT_DIM // 2
    inv_freq = ROPE_THETA ** (-jnp.arange(half, dtype=jnp.float32) * 2.0 / ROT_DIM)
    ang = pos.astype(jnp.float32)[:, None] * inv_freq[None, :]
    cos = jnp.cos(ang)[None, :, None, :]
    sin = jnp.sin(ang)[None, :, None, :]
    xr = x[..., :ROT_DIM].astype(jnp.float32)
    x1, x2 = xr[..., :half], xr[..., half:]
    rot = jnp.concatenate([x1 * cos - x2 * sin, x2 * cos + x1 * sin], axis=-1).astype(x.dtype)
    return jnp.concatenate([rot, x[..., ROT_DIM:]], axis=-1)


def chunked_gmlp(z, ln_g, ln_b, w_s, b_s):
    B, S, _ = z.shape
    z = jax.nn.gelu(z)
    u, v = z[..., :GMLP_WIDTH], z[..., GMLP_WIDTH:]
    v = layernorm(v, ln_g, ln_b)
    v = v.reshape(B, S // CHUNK, CHUNK, GMLP_GROUPS, HEAD_DIM)
    causal = jnp.tril(jnp.ones((CHUNK, CHUNK), dtype=bool))
    w = jnp.where(causal[None], w_s, jnp.zeros_like(w_s))
    mixed = jnp.einsum('gts,bcsgd->bctgd', w, v) + b_s.T[None, None, :, :, None]
    return u * mixed.reshape(B, S, GMLP_WIDTH)


def forgetting_attention(q, k, v, f_logit, q_g, k_g):
    B, S, H, Dh = q.shape
    q = rmsnorm(q, q_g)
    k = rmsnorm(k, k_g)
    c = jnp.cumsum(jax.nn.log_sigmoid(f_logit.astype(jnp.float32)), axis=1)
    c_k = c.transpose(0, 2, 1)
    n_blk = S // Q_BLOCK
    q_blocks = q.reshape(B, n_blk, Q_BLOCK, H, Dh).transpose(1, 0, 2, 3, 4)
    c_blocks = c.reshape(B, n_blk, Q_BLOCK, H).transpose(1, 0, 3, 2)
    k_pos = jnp.arange(S)
    scale = Dh ** -0.5

    def one_block(args):
        q_i, c_i, i = args
        s = jnp.einsum('bqhd,bkhd->bhqk', q_i, k, preferred_element_type=jnp.float32) * scale
        s = s + c_i[..., :, None] - c_k[:, :, None, :]
        q_pos = i * Q_BLOCK + jnp.arange(Q_BLOCK)
        s = jnp.where(q_pos[:, None] >= k_pos[None, :], s, -jnp.inf)
        prob = jax.nn.softmax(s, axis=-1)
        return jnp.einsum('bhqk,bkhd->bqhd', prob.astype(v.dtype), v)

    out = lax.map(one_block, (q_blocks, c_blocks, jnp.arange(n_blk)))
    return out.transpose(1, 0, 2, 3, 4).reshape(B, S, H * Dh)


def sliding_window_attention(q, k, v, sinks, q_g, k_g, pos):
    B, S, _, Dh = q.shape
    q = partial_rope(rmsnorm(q, q_g), pos)
    k = partial_rope(rmsnorm(k, k_g), pos)
    n_blk = S // WINDOW
    qb = q.reshape(B, n_blk, WINDOW, SWA_KV_HEADS, SWA_GROUP, Dh)

    def band(t):
        tb = t.reshape(B, n_blk, WINDOW, SWA_KV_HEADS, Dh)
        prev = jnp.pad(tb, ((0, 0), (1, 0), (0, 0), (0, 0), (0, 0)))[:, :-1]
        return jnp.concatenate([prev, tb], axis=2)

    kb, vb = band(k), band(v)
    s = jnp.einsum('bnqkgd,bnskd->bnkgqs', qb, kb, preferred_element_type=jnp.float32) * (Dh ** -0.5)
    i = jnp.arange(WINDOW)[:, None]
    j = jnp.arange(2 * WINDOW)[None, :]
    in_band = (j > i) & (j <= i + WINDOW)
    not_pad = (jnp.arange(n_blk)[:, None, None] > 0) | (j >= WINDOW)[None]
    mask = in_band[None] & not_pad
    s = jnp.where(mask[None, :, None, None], s, -jnp.inf)
    sink = sinks.astype(jnp.float32).reshape(SWA_KV_HEADS, SWA_GROUP)[None, None, :, :, None, None]
    sink = jnp.broadcast_to(sink, s.shape[:-1] + (1,))
    prob = jax.nn.softmax(jnp.concatenate([s, sink], axis=-1), axis=-1)[..., :-1]
    o = jnp.einsum('bnkgqs,bnskd->bnqkgd', prob.astype(v.dtype), vb)
    return o.reshape(B, S, SWA_WIDTH)


def conformer_conv(z, w_dw, ln_g, ln_b):
    a, gate = z[..., :CONV_CH], z[..., CONV_CH:]
    h = a * jax.nn.sigmoid(gate)
    h = lax.conv_general_dilated(h, w_dw[:, None, :].astype(h.dtype), window_strides=(1,),
                                 padding=((CONV_WIDTH - 1, 0),),
                                 dimension_numbers=('NWC', 'WIO', 'NWC'),
                                 feature_group_count=CONV_CH)
    h = layernorm(h, ln_g, ln_b)
    return jax.nn.silu(h)


def hierarchical_moe(x, w_coarse, b_coarse, w_fine, b_fine, w_gate, w_up, w_down):
    coarse = (x @ w_coarse).astype(jnp.float32) + b_coarse.astype(jnp.float32)
    p_coarse = jax.nn.softmax(coarse, axis=-1)
    g_idx = jnp.argmax(coarse, axis=-1)
    p_g = jnp.take_along_axis(p_coarse, g_idx[:, None], axis=-1)
    fine_all = jnp.einsum('td,gde->tge', x, w_fine).astype(jnp.float32) + b_fine.astype(jnp.float32)
    fine = jnp.take_along_axis(fine_all, g_idx[:, None, None], axis=1)[:, 0]
    top_v, top_i = lax.top_k(fine, TOP_K)
    p_e = jax.nn.softmax(top_v, axis=-1) * p_g
    expert_id = g_idx[:, None] * EXPERTS_PER_GROUP + top_i
    combine = jnp.einsum('tk,tke->te', p_e, jax.nn.one_hot(expert_id, N_EXPERTS, dtype=jnp.float32))
    h = jax.nn.silu(jnp.einsum('td,edf->tef', x, w_gate)) * jnp.einsum('td,edf->tef', x, w_up)
    h = h * combine.astype(h.dtype)[..., None]
    return jnp.einsum('tef,efd->td', h, w_down)


def setup_inputs(seed: int = 0) -> dict:
    key = jax.random.key(seed)
    ks = jax.random.split(key, 32)
    f32 = jnp.float32

    def nrm(k, shape, scale):
        return jax.random.normal(k, shape, f32) * scale

    def gain(k, shape):
        return 1.0 + 0.05 * jax.random.normal(k, shape, f32)

    D = D_MODEL
    return {
        'x': nrm(ks[0], (BATCH, SEQ, D), 1.0),
        'p': nrm(ks[1], (DEPTH, BATCH, SEQ, D_PLE), 1.0),
        'norm_mix': gain(ks[2], (DEPTH, D)),
        'even_w_in': nrm(ks[3], (N_EVEN, D, EVEN_IN), D ** -0.5),
        'fox_b_f': 2.0 + 0.5 * jax.random.normal(ks[4], (N_EVEN, FOX_HEADS), f32),
        'gmlp_ln_g': gain(ks[5], (N_EVEN, GMLP_WIDTH)),
        'gmlp_ln_b': nrm(ks[6], (N_EVEN, GMLP_WIDTH), 0.02),
        'gmlp_w_s': nrm(ks[7], (N_EVEN, GMLP_GROUPS, CHUNK, CHUNK), CHUNK ** -0.5),
        'gmlp_b_s': 1.0 + 0.1 * jax.random.normal(ks[8], (N_EVEN, GMLP_GROUPS, CHUNK), f32),
        'fox_q_norm': gain(ks[9], (N_EVEN, HEAD_DIM)),
        'fox_k_norm': gain(ks[10], (N_EVEN, HEAD_DIM)),
        'even_w_out': nrm(ks[11], (N_EVEN, GMLP_WIDTH + FOX_WIDTH, D), (GMLP_WIDTH + FOX_WIDTH) ** -0.5),
        'odd_w_in': nrm(ks[12], (N_ODD, D, ODD_IN), D ** -0.5),
        'swa_q_norm': gain(ks[13], (N_ODD, HEAD_DIM)),
        'swa_k_norm': gain(ks[14], (N_ODD, HEAD_DIM)),
        'swa_sinks': nrm(ks[15], (N_ODD, SWA_Q_HEADS), 0.5),
        'conv_w': nrm(ks[16], (N_ODD, CONV_WIDTH, CONV_CH), CONV_WIDTH ** -0.5),
        'conv_ln_g': gain(ks[17], (N_ODD, CONV_CH)),
        'conv_ln_b': nrm(ks[18], (N_ODD, CONV_CH), 0.02),
        'odd_w_out': nrm(ks[19], (N_ODD, SWA_WIDTH + CONV_CH, D), (SWA_WIDTH + CONV_CH) ** -0.5),
        'norm_ffn': gain(ks[20], (DEPTH, D)),
        'moe_w_coarse': nrm(ks[21], (DEPTH, D, N_GROUPS), D ** -0.5),
        'moe_b_coarse': nrm(ks[22], (DEPTH, N_GROUPS), 0.01),
        'moe_w_fine': nrm(ks[23], (DEPTH, N_GROUPS, D, EXPERTS_PER_GROUP), D ** -0.5),
        'moe_b_fine': nrm(ks[24], (DEPTH, N_GROUPS, EXPERTS_PER_GROUP), 0.01),
        'moe_w_gate': nrm(ks[25], (DEPTH, N_EXPERTS, D, D_EXPERT), D ** -0.5),
        'moe_w_up': nrm(ks[26], (DEPTH, N_EXPERTS, D, D_EXPERT), D ** -0.5),
        'moe_w_down': nrm(ks[27], (DEPTH, N_EXPERTS, D_EXPERT, D), D_EXPERT ** -0.5),
        'ple_w_proj': nrm(ks[28], (DEPTH, D_PLE, D), D_PLE ** -0.5),
        'ple_norm': gain(ks[29], (DEPTH, D)),
        'ple_w_gate': nrm(ks[30], (DEPTH, D, D), D ** -0.5),
    }


def reference(x, p, norm_mix, even_w_in, fox_b_f, gmlp_ln_g, gmlp_ln_b, gmlp_w_s, gmlp_b_s,
              fox_q_norm, fox_k_norm, even_w_out, odd_w_in, swa_q_norm, swa_k_norm, swa_sinks,
              conv_w, conv_ln_g, conv_ln_b, odd_w_out, norm_ffn, moe_w_coarse, moe_b_coarse,
              moe_w_fine, moe_b_fine, moe_w_gate, moe_w_up, moe_w_down, ple_w_proj, ple_norm,
              ple_w_gate):
    B, S, D = x.shape
    pos = jnp.arange(S)
    h = x
    for i in range(DEPTH):
        a = rmsnorm(h, norm_mix[i])
        j = i // 2
        if i % 2 == 0:
            z = a @ even_w_in[j]
            z_a, q, k, v, f = jnp.split(z, EVEN_SPLITS, axis=-1)
            y_a = chunked_gmlp(z_a, gmlp_ln_g[j], gmlp_ln_b[j], gmlp_w_s[j], gmlp_b_s[j])
            y_b = forgetting_attention(q.reshape(B, S, FOX_HEADS, HEAD_DIM),
                                       k.reshape(B, S, FOX_HEADS, HEAD_DIM),
                                       v.reshape(B, S, FOX_HEADS, HEAD_DIM),
                                       f + fox_b_f[j], fox_q_norm[j], fox_k_norm[j])
            mix = jnp.concatenate([y_a, y_b], axis=-1) @ even_w_out[j]
        else:
            z = a @ odd_w_in[j]
            q, k, v, z_d = jnp.split(z, ODD_SPLITS, axis=-1)
            y_c = sliding_window_attention(q.reshape(B, S, SWA_Q_HEADS, HEAD_DIM),
                                           k.reshape(B, S, SWA_KV_HEADS, HEAD_DIM),
                                           v.reshape(B, S, SWA_KV_HEADS, HEAD_DIM),
                                           swa_sinks[j], swa_q_norm[j], swa_k_norm[j], pos)
            y_d = conformer_conv(z_d, conv_w[j], conv_ln_g[j], conv_ln_b[j])
            mix = jnp.concatenate([y_c, y_d], axis=-1) @ odd_w_out[j]
        h = h + mix
        m = rmsnorm(h, norm_ffn[i]).reshape(B * S, D)
        h = h + hierarchical_moe(m, moe_w_coarse[i], moe_b_coarse[i], moe_w_fine[i], moe_b_fine[i],
                                 moe_w_gate[i], moe_w_up[i], moe_w_down[i]).reshape(B, S, D)
        gate = jax.nn.sigmoid(rmsnorm(h, ple_norm[i]) @ ple_w_gate[i])
        h = h + gate * (p[i] @ ple_w_proj[i])
    return h
```

```cpp
#define MK_CFG 0
#define MK_PLO 0
#define MK_PHI 0
#define MK_REP 1
#define MK_PFLAGS 3
#include <hip/hip_runtime.h>
#include <cstdio>
#include <cstdint>
namespace mk {
constexpr int NWAVES = 8;
constexpr int T = 16384, D = 1024, SEQ = 2048, NB = 8, NE = 32, DEXP = 256, DPLE = 256;
constexpr int EVEN_IN = 2568, ODD_IN = 1792, N_IN0 = 2560, N_IN1 = 1792;
constexpr int ROWS_MAX = T * 2 + NE * 256;
constexpr float EPS = 1e-6f;
constexpr size_t MiB = 1u << 20;
constexpr size_t WS_CTL = 0, CTL_ZERO_BYTES = 1 * MiB;
constexpr size_t WS_SSQ = 1 * MiB;
constexpr size_t WS_GST = 2 * MiB;
constexpr size_t WS_EID = 3 * MiB, WS_EW = WS_EID + 128 * 1024, WS_TOKPOS = WS_EW + 128 * 1024, WS_ROWW = WS_TOKPOS + 128 * 1024, WS_ROWRS = WS_ROWW + 160 * 1024, WS_LRANK = WS_ROWRS + 160 * 1024, WS_BCNT = WS_LRANK + 128 * 1024, WS_ROWTOK = WS_BCNT + 32 * 1024;
constexpr size_t WS_RW = 4 * MiB;
constexpr size_t WS_RB = WS_RW + 2 * 48 * 1024 * 4;
constexpr size_t WS_GW = WS_RB + 4096;
constexpr size_t WS_ROPE = WS_GW + 8 * 128 * 128 * 2;
constexpr size_t WS_CFL = 5 * MiB;
constexpr size_t WS_WIN0 = 6 * MiB, WS_WOUT0 = 11 * MiB, WS_WIN1 = 13 * MiB, WS_WOUT1 = 17 * MiB, WS_WPG = 19 * MiB, WS_WPP = 23 * MiB, WS_W1 = 24 * MiB, WS_W2 = 88 * MiB;
constexpr size_t WS_HB = 120 * MiB;
constexpr size_t WS_PB = 152 * MiB;
constexpr size_t WS_PP = 168 * MiB;
constexpr size_t WS_Y = 200 * MiB, WS_VG = 232 * MiB, WS_KB = 248 * MiB, WS_VB = 264 * MiB;
constexpr size_t WS_MG = 200 * MiB;
constexpr size_t WS_HID = 280 * MiB;
constexpr size_t WS_SSQ2 = 300 * MiB;
constexpr size_t WS_END = 301 * MiB;
__host__ __device__ constexpr size_t ws_hb(int layer) { return layer ? WS_W1 : WS_HB; }
__host__ __device__ constexpr size_t ws_ssq(int layer) { return layer ? WS_SSQ2 : WS_SSQ; }
constexpr int CW_TMO = 0;
constexpr int CW_CNT = 64, CW_CUR = 128;
constexpr int CW_QHEAD = 192, CW_ARRIVE = 1024;
constexpr int CW_BAR = 4096;
constexpr int RING_BYTES = 131072, MISC_OFF = RING_BYTES, LDS_BYTES = 147456;

__device__ __forceinline__ const float* in_ptr(int i) {
    const __attribute__((address_space(4))) char* ka = (const __attribute__((address_space(4))) char*)__builtin_amdgcn_kernarg_segment_ptr();
    asm volatile("" : "+s"(ka));
    return *(const float* const __attribute__((address_space(4)))*)(ka + 8 * i);
}
typedef unsigned wt_u32x4 __attribute__((ext_vector_type(4)));
typedef unsigned wt_u32x2 __attribute__((ext_vector_type(2)));
__device__ __forceinline__ __amdgpu_buffer_rsrc_t ws_rsrc(const void* ws) { return __builtin_amdgcn_make_buffer_rsrc((void*)ws, 0, 0x7ffffff0, 0x00020000); }
#ifndef MK_WT
#define MK_WT 0
#endif
__device__ __forceinline__ void wt16(__amdgpu_buffer_rsrc_t r, const void* ws, const void* p, wt_u32x4 v) { if (MK_WT & 1) __builtin_amdgcn_raw_buffer_store_b128(v, r, (int)((const unsigned char*)p - (const unsigned char*)ws), 0, 16); else *(wt_u32x4*)p = v; }
__device__ __forceinline__ void wt16c(__amdgpu_buffer_rsrc_t r, const void* ws, const void* p, wt_u32x4 v) { if (MK_WT & 2) __builtin_amdgcn_raw_buffer_store_b128(v, r, (int)((const unsigned char*)p - (const unsigned char*)ws), 0, 16); else *(wt_u32x4*)p = v; }
__device__ __forceinline__ void wt8(__amdgpu_buffer_rsrc_t r, const void* ws, const void* p, wt_u32x2 v) { if (MK_WT & 1) __builtin_amdgcn_raw_buffer_store_b64(v, r, (int)((const unsigned char*)p - (const unsigned char*)ws), 0, 16); else *(wt_u32x2*)p = v; }
__device__ __forceinline__ int lane_id() { return (int)__builtin_amdgcn_mbcnt_hi(~0u, __builtin_amdgcn_mbcnt_lo(~0u, 0u)); }
template <int M> __device__ __forceinline__ float xor_lane(float v) {
    if constexpr (M == 32) { auto rr = __builtin_amdgcn_permlane32_swap(__float_as_uint(v), __float_as_uint(v), false, false); return __uint_as_float(rr[0]) == v ? __uint_as_float(rr[1]) : __uint_as_float(rr[0]); }
    else return __builtin_bit_cast(float, __builtin_amdgcn_ds_swizzle(__builtin_bit_cast(int, v), (M << 10) | 0x1f));
}
__device__ __forceinline__ float sum_xor32(float v) { auto rr = __builtin_amdgcn_permlane32_swap(__float_as_uint(v), __float_as_uint(v), false, false); return __uint_as_float(rr[0]) + __uint_as_float(rr[1]); }
template <int CTRL> __device__ __forceinline__ float dpp_f(float v) { return __builtin_bit_cast(float, __builtin_amdgcn_update_dpp(0, __builtin_bit_cast(int, v), CTRL, 0xf, 0xf, true)); }
__device__ __forceinline__ float wave_sum64(float v) { v += dpp_f<0xB1>(v); v += dpp_f<0x4E>(v); v += dpp_f<0x141>(v); v += dpp_f<0x140>(v); v += xor_lane<16>(v); return sum_xor32(v); }
}
namespace pg8 {
#define PG8_LAS __attribute__((address_space(3)))
typedef unsigned short bf16_t;
typedef short bf16x8 __attribute__((ext_vector_type(8)));
typedef float f32x4 __attribute__((ext_vector_type(4)));
typedef unsigned u32x4 __attribute__((ext_vector_type(4)));
constexpr int BM = 256, BK = 64, HALF = 128, HTB = HALF * BK * 2  , STAGE_BYTES = 8 * HTB, NXCD = 8, WGM = 8;

__host__ __device__ __forceinline__ int lds_byte(int r, int c) { const int st = (r >> 4) * 2 + (c >> 5), rr = r & 15, cc = c & 31, ob = rr * 64 + cc * 2; return st * 1024 + (ob ^ (((ob >> 9) & 1) << 5)); }
__host__ __device__ __forceinline__ void stage_rc(int b, int& R, int& C) { const int st = b / 1024, sb = b % 1024, swz = sb ^ (((sb >> 9) & 1) << 5); R = (st >> 1) * 16 + swz / 64; C = (st & 1) * 32 + (swz % 64) / 2; }
__host__ __device__ __forceinline__ int perm32(int rho) { const int n = rho >> 4, i = rho & 15; return 8 * (i >> 2) + 4 * n + (i & 3); }

struct Unit { int pm, pn, pc; };
struct Gemm { const bf16_t* A; const bf16_t* Bt; int M, N, K; };

struct StaticOrder {
    int nM, nN, nwg, G, c;
    __host__ __device__ void init(int M, int N, int G_, int c_) { nM = M / BM; nN = N / BM; nwg = nM * nN; G = G_; c = c_; }
    __host__ __device__ bool next(int i, Unit& u) const {
        const long L = (long)i * G + c; if (L >= nwg) return false;
        int wgid = (int)L; { const int q = nwg / NXCD, r = nwg % NXCD, xcd = wgid % NXCD, off = wgid / NXCD; wgid = (xcd < r ? xcd * (q + 1) : r * (q + 1) + (xcd - r) * q) + off; }
        const int nig = WGM * nN, gid = wgid / nig, fm = gid * WGM, gsz = (nM - fm) < WGM ? (nM - fm) : WGM;
        u.pm = fm + ((wgid % nig) % gsz); u.pn = (wgid % nig) / gsz; u.pc = u.pn; return true;
    }
    __device__ __forceinline__ void a_ready(const Unit&) const {}
    __device__ __forceinline__ void done(const Unit&) const {}
};

typedef float f32x2 __attribute__((ext_vector_type(2)));
typedef __bf16 bf16x2_t __attribute__((ext_vector_type(2)));
constexpr float EPS = 1e-6f, LOG2E = 1.4426950408889634f, C2 = 0.125f * 1.4426950408889634f;
__device__ __forceinline__ unsigned cvt_pk_bf16(float lo, float hi) { f32x2 v = {lo, hi}; bf16x2_t b = __builtin_convertvector(v, bf16x2_t); return __builtin_bit_cast(unsigned, b); }
__device__ __forceinline__ float bf_lo(unsigned w) { return __builtin_bit_cast(float, w << 16); }
__device__ __forceinline__ float bf_hi(unsigned w) { return __builtin_bit_cast(float, w & 0xffff0000u); }
__device__ __forceinline__ float fast_sigmoid(float x) { return __builtin_amdgcn_rcpf(1.f + __builtin_amdgcn_exp2f(-LOG2E * x)); }
__device__ __forceinline__ float fast_silu(float x) { return x * fast_sigmoid(x); }
__device__ __forceinline__ float fast_gelu_tanh(float x) { const float t = x + 0.044715f * x * x * x; return x * __builtin_amdgcn_rcpf(1.f + __builtin_amdgcn_exp2f(-2.302208198f * t)); }
__device__ __forceinline__ void store8(__amdgpu_buffer_rsrc_t R, const void* ws, bf16_t* p, const f32x4 v0, const f32x4 v1) { u32x4 w; w.x = cvt_pk_bf16(v0[0], v0[1]); w.y = cvt_pk_bf16(v0[2], v0[3]); w.z = cvt_pk_bf16(v1[0], v1[1]); w.w = cvt_pk_bf16(v1[2], v1[3]); mk::wt16(R, ws, p, w); }
__device__ __forceinline__ float quad_sum(float s) { s += mk::xor_lane<16>(s); return mk::sum_xor32(s); }
__device__ __forceinline__ float row_rstd(const float* ssq, int row, int fq) {
    const f32x4 p = *(const f32x4*)(ssq + (size_t)row * 16 + 4 * fq);
    return rsqrtf(quad_sum((p[0] + p[1]) + (p[2] + p[3])) * (1.f / 1024.f) + EPS);
}
__device__ __forceinline__ void rows_rstd(const float* ssq, int row0, int fq, float (&rs)[2][4]) {
    f32x4 p[2][4];
#pragma unroll
    for (int ai = 0; ai < 2; ++ai)
#pragma unroll
        for (int m = 0; m < 4; ++m) p[ai][m] = *(const f32x4*)(ssq + (size_t)(row0 + ai * HALF + m * 16) * 16 + 4 * fq);
#pragma unroll
    for (int ai = 0; ai < 2; ++ai)
#pragma unroll
        for (int m = 0; m < 4; ++m) rs[ai][m] = rsqrtf(quad_sum((p[ai][m][0] + p[ai][m][1]) + (p[ai][m][2] + p[ai][m][3])) * (1.f / 1024.f) + EPS);
}
__device__ __forceinline__ float sumsq8(const f32x4 a, const f32x4 b) { return (a[0] * a[0] + a[1] * a[1]) + (a[2] * a[2] + a[3] * a[3]) + (b[0] * b[0] + b[1] * b[1]) + (b[2] * b[2] + b[3] * b[3]); }

struct EpBf16 {
    static constexpr bool PERM = true, AFTER_DRAIN = false;
    bf16_t* O; long ldc; unsigned char* ws;
    __device__ __forceinline__ void operator()(const f32x4 (&acc)[2][2][4][2], const Unit& u, int wr, int wc, int fr, int fq) const {
        asm volatile("" : "+v"(fr), "+v"(fq));
        const __amdgpu_buffer_rsrc_t R_ = mk::ws_rsrc(ws);
        if (ldc < 0) { asm volatile("" :: "v"(acc[0][0][0][0]), "v"(acc[1][1][3][1])); return; }
        const int row0 = u.pm * BM + wr * 64 + fr, col0 = u.pc * BM + wc * 32 + 8 * fq;
#pragma unroll
        for (int ai = 0; ai < 2; ++ai)
#pragma unroll
            for (int m = 0; m < 4; ++m) { bf16_t* rowp = O + (size_t)(row0 + ai * HALF + m * 16) * ldc + col0;
#pragma unroll
                for (int bj = 0; bj < 2; ++bj) store8(R_, ws, rowp + bj * HALF, acc[ai][bj][m][0], acc[ai][bj][m][1]); }
    }
};

struct EpIn0 {
    static constexpr bool PERM = true, AFTER_DRAIN = false;
    unsigned char* ws;
    __device__ __forceinline__ void operator()(const f32x4 (&acc)[2][2][4][2], const Unit& u, int wr, int wc, int fr, int fq) const {
        asm volatile("" : "+v"(fr), "+v"(fq));
        const __amdgpu_buffer_rsrc_t R_ = mk::ws_rsrc(ws);
        const float* ssq = (const float*)(ws + mk::ws_ssq(0)); bf16_t* Y = (bf16_t*)(ws + mk::WS_Y); bf16_t* VG = (bf16_t*)(ws + mk::WS_VG); float* gst = (float*)(ws + mk::WS_GST); bf16_t* KB = (bf16_t*)(ws + mk::WS_KB); bf16_t* VB = (bf16_t*)(ws + mk::WS_VB);
        const int pn = u.pn, row0 = u.pm * BM + wr * 64 + fr, cw = wc * 32 + 8 * fq;
        float rs8[2][4]; rows_rstd(ssq, row0, fq, rs8);
        f32x4 gv[2][2];
        if (pn >= 4 && pn < 8) { const float* g = pn < 6 ? mk::in_ptr(9) : mk::in_ptr(10);
#pragma unroll
            for (int bj = 0; bj < 2; ++bj)
#pragma unroll
                for (int n = 0; n < 2; ++n) { gv[bj][n] = *(const f32x4*)(g + 32 * bj + 8 * fq + 4 * n); if (pn < 6) gv[bj][n] = gv[bj][n] * C2; } }
#pragma unroll
        for (int ai = 0; ai < 2; ++ai)
#pragma unroll
            for (int m = 0; m < 4; ++m) {
                const int row = row0 + ai * HALF + m * 16;
                const float rs = rs8[ai][m];
                if (pn < 2) {
#pragma unroll
                    for (int bj = 0; bj < 2; ++bj) { f32x4 v0 = acc[ai][bj][m][0] * rs, v1 = acc[ai][bj][m][1] * rs;
#pragma unroll
                        for (int i = 0; i < 4; ++i) { v0[i] = fast_gelu_tanh(v0[i]); v1[i] = fast_gelu_tanh(v1[i]); }
                        store8(R_, ws, Y + (size_t)row * 1024 + pn * 256 + bj * HALF + cw, v0, v1); }
                } else if (pn < 4) {
                    float s = 0.f, q = 0.f;
#pragma unroll
                    for (int bj = 0; bj < 2; ++bj) { f32x4 v0 = acc[ai][bj][m][0] * rs, v1 = acc[ai][bj][m][1] * rs;
#pragma unroll
                        for (int i = 0; i < 4; ++i) { v0[i] = fast_gelu_tanh(v0[i]); v1[i] = fast_gelu_tanh(v1[i]); }
                        s += (v0[0] + v0[1]) + (v0[2] + v0[3]) + (v1[0] + v1[1]) + (v1[2] + v1[3]); q += sumsq8(v0, v1);
                        store8(R_, ws, VG + (size_t)row * 512 + (pn - 2) * 256 + bj * HALF + cw, v0, v1); }
                    s = quad_sum(s); q = quad_sum(q);
                    if (fq == 0) *(f32x2*)(gst + (size_t)row * 16 + ((pn - 2) * 4 + wc) * 2) = (f32x2){s, q};
                } else if (pn < 8) {
                    f32x4 v[2][2]; float ss = 0.f;
#pragma unroll
                    for (int bj = 0; bj < 2; ++bj) { v[bj][0] = acc[ai][bj][m][0] * rs; v[bj][1] = acc[ai][bj][m][1] * rs; ss += sumsq8(v[bj][0], v[bj][1]); }
                    const float hr = rsqrtf(quad_sum(ss) * (1.f / 64.f) + EPS);
                    const int head = (pn & 1) * 4 + wc;
                    bf16_t* dst = (pn < 6 ? Y + (size_t)row * 1024 + 512 : KB + (size_t)row * 512) + head * 64 + 8 * fq;
#pragma unroll
                    for (int bj = 0; bj < 2; ++bj) store8(R_, ws, dst + 32 * bj, v[bj][0] * hr * gv[bj][0], v[bj][1] * hr * gv[bj][1]);
                } else {
#pragma unroll
                    for (int bj = 0; bj < 2; ++bj) store8(R_, ws, VB + (size_t)row * 512 + (pn - 8) * 256 + bj * HALF + cw, acc[ai][bj][m][0] * rs, acc[ai][bj][m][1] * rs);
                }
            }
    }
};

struct EpIn1 {
    static constexpr bool PERM = true, AFTER_DRAIN = false;
    unsigned char* ws;
    __device__ __forceinline__ void operator()(const f32x4 (&acc)[2][2][4][2], const Unit& u, int wr, int wc, int fr, int fq) const {
        asm volatile("" : "+v"(fr), "+v"(fq));
        const __amdgpu_buffer_rsrc_t R_ = mk::ws_rsrc(ws);
        const float* ssq = (const float*)(ws + mk::ws_ssq(1)); bf16_t* Y = (bf16_t*)(ws + mk::WS_Y); bf16_t* K1 = (bf16_t*)(ws + mk::WS_KB); bf16_t* V1 = (bf16_t*)(ws + mk::WS_VB); bf16_t* HG = (bf16_t*)(ws + mk::WS_VG); const float* rope = (const float*)(ws + mk::WS_ROPE);
        const int pn = u.pn, row0 = u.pm * BM + wr * 64 + fr;
        float rs8[2][4]; rows_rstd(ssq, row0, fq, rs8);
        const bool isq = pn < 2, isk = (pn == 2 && wc < 2), isv = (pn == 2 && wc >= 2);
        f32x4 gv[2][2];
        if (isq || isk) { const float* g = isq ? mk::in_ptr(13) : mk::in_ptr(14);
#pragma unroll
            for (int bj = 0; bj < 2; ++bj)
#pragma unroll
                for (int n = 0; n < 2; ++n) { gv[bj][n] = *(const f32x4*)(g + 32 * bj + 8 * fq + 4 * n); if (isq) gv[bj][n] = gv[bj][n] * C2; } }
#pragma unroll
        for (int ai = 0; ai < 2; ++ai)
#pragma unroll
            for (int m = 0; m < 4; ++m) {
                const int row = row0 + ai * HALF + m * 16;
                const float rs = rs8[ai][m];
                if (pn < 3) {
                    f32x4 v[2][2]; float ss = 0.f;
#pragma unroll
                    for (int bj = 0; bj < 2; ++bj) { v[bj][0] = acc[ai][bj][m][0] * rs; v[bj][1] = acc[ai][bj][m][1] * rs; ss += sumsq8(v[bj][0], v[bj][1]); }
                    ss = quad_sum(ss);
                    if (!isv) {
                        const float hr = rsqrtf(ss * (1.f / 64.f) + EPS);
#pragma unroll
                        for (int bj = 0; bj < 2; ++bj) { v[bj][0] = v[bj][0] * hr * gv[bj][0]; v[bj][1] = v[bj][1] * hr * gv[bj][1]; }
                        const f32x4 c0 = *(const f32x4*)(rope + (size_t)(row & 2047) * 16), c1 = *(const f32x4*)(rope + (size_t)(row & 2047) * 16 + 4);
                        const f32x4 s0 = *(const f32x4*)(rope + (size_t)(row & 2047) * 16 + 8), s1 = *(const f32x4*)(rope + (size_t)(row & 2047) * 16 + 12);
                        f32x4 o0, o1;
#pragma unroll
                        for (int i = 0; i < 4; ++i) { o0[i] = mk::xor_lane<16>(v[0][0][i]); o1[i] = mk::xor_lane<16>(v[0][1][i]); }
                        if (fq == 0) { v[0][0] = v[0][0] * c0 - o0 * s0; v[0][1] = v[0][1] * c1 - o1 * s1; }
                        else if (fq == 1) { v[0][0] = v[0][0] * c0 + o0 * s0; v[0][1] = v[0][1] * c1 + o1 * s1; }
                    }
                    bf16_t* dst = isq ? Y + (size_t)row * 1024 + (pn * 4 + wc) * 64 : (isk ? K1 + (size_t)row * 128 + wc * 64 : V1 + (size_t)row * 128 + (wc - 2) * 64);
#pragma unroll
                    for (int bj = 0; bj < 2; ++bj) store8(R_, ws, dst + 32 * bj + 8 * fq, v[bj][0], v[bj][1]);
                } else {
                    f32x4 a0 = acc[ai][0][m][0] * rs, a1 = acc[ai][0][m][1] * rs; const f32x4 g0 = acc[ai][1][m][0] * rs, g1 = acc[ai][1][m][1] * rs;
#pragma unroll
                    for (int i = 0; i < 4; ++i) { a0[i] *= fast_sigmoid(g0[i]); a1[i] *= fast_sigmoid(g1[i]); }
                    store8(R_, ws, HG + (size_t)row * 512 + (pn - 3) * 128 + wc * 32 + 8 * fq, a0, a1);
                }
            }
    }
};

template <bool GATE> struct EpRes {
    static constexpr bool PERM = true, AFTER_DRAIN = false;
    float* out; unsigned char* ws; int layer;
    __device__ __forceinline__ void operator()(const f32x4 (&acc)[2][2][4][2], const Unit& u, int wr, int wc, int fr, int fq) const {
        asm volatile("" : "+v"(fr), "+v"(fq));
        const __amdgpu_buffer_rsrc_t R_ = mk::ws_rsrc(ws);
        const int lo_ = GATE ? (layer ^ 1) : layer; const bool fin = GATE && layer == 1;
        const bf16_t* res = (const bf16_t*)(ws + mk::ws_hb(layer)); bf16_t* hb = (bf16_t*)(ws + mk::ws_hb(lo_)); float* ssq_out = (float*)(ws + mk::ws_ssq(lo_)); const float* ssq_in = (const float*)(ws + mk::ws_ssq(layer)); const bf16_t* pp = (const bf16_t*)(ws + mk::WS_PP);
        const int row0 = u.pm * BM + wr * 64 + fr, col0 = u.pc * BM + wc * 32 + 8 * fq;
        float rs8[2][4];
        if (GATE) rows_rstd(ssq_in, row0, fq, rs8);
#pragma unroll
        for (int ap = 0; ap < 4; ++ap) {
            const int ai = ap >> 1, mb = (ap & 1) * 2;
            u32x4 rw[2][2], pw[2][2];
#pragma unroll
            for (int mm = 0; mm < 2; ++mm)
#pragma unroll
                for (int bj = 0; bj < 2; ++bj) { const size_t off = (size_t)(row0 + ai * HALF + (mb + mm) * 16) * 1024 + col0 + bj * HALF; rw[mm][bj] = *(const u32x4*)(res + off); if (GATE) pw[mm][bj] = __builtin_nontemporal_load((const u32x4*)(pp + off)); }
#pragma unroll
            for (int mm = 0; mm < 2; ++mm) {
                const int m = mb + mm;
                const int row = row0 + ai * HALF + m * 16; const size_t off = (size_t)row * 1024 + col0;
                const float rs = GATE ? rs8[ai][m] : 1.f;
                float ss = 0.f;
#pragma unroll
                for (int bj = 0; bj < 2; ++bj) {
                    f32x4 v0 = acc[ai][bj][m][0], v1 = acc[ai][bj][m][1];
                    const u32x4 r_ = rw[mm][bj];
                    const f32x4 r0 = {bf_lo(r_.x), bf_hi(r_.x), bf_lo(r_.y), bf_hi(r_.y)}, r1 = {bf_lo(r_.z), bf_hi(r_.z), bf_lo(r_.w), bf_hi(r_.w)};
                    if (GATE) { const u32x4 p_ = pw[mm][bj];
                        const f32x4 p0 = {bf_lo(p_.x), bf_hi(p_.x), bf_lo(p_.y), bf_hi(p_.y)}, p1 = {bf_lo(p_.z), bf_hi(p_.z), bf_lo(p_.w), bf_hi(p_.w)};
#pragma unroll
                        for (int i = 0; i < 4; ++i) { v0[i] = fast_sigmoid(v0[i] * rs) * p0[i]; v1[i] = fast_sigmoid(v1[i] * rs) * p1[i]; } }
                    v0 = v0 + r0; v1 = v1 + r1;
                    if (fin) { *(f32x4*)(out + off + bj * HALF) = v0; *(f32x4*)(out + off + bj * HALF + 4) = v1; }
                    else { store8(R_, ws, hb + off + bj * HALF, v0, v1); ss += sumsq8(v0, v1); }
                }
                if (!fin) { ss = quad_sum(ss); if (fq == 0) ssq_out[(size_t)row * 16 + u.pc * 4 + wc] = ss; }
            }
        }
    }
};

struct EpMoe1 {
    static constexpr bool PERM = true, AFTER_DRAIN = false;
    unsigned char* ws;
    __device__ __forceinline__ void operator()(const f32x4 (&acc)[2][2][4][2], const Unit& u, int wr, int wc, int fr, int fq) const {
        asm volatile("" : "+v"(fr), "+v"(fq));
        const __amdgpu_buffer_rsrc_t R_ = mk::ws_rsrc(ws);
        const float* rowrs = (const float*)(ws + mk::WS_ROWRS); const float* roww = (const float*)(ws + mk::WS_ROWW); bf16_t* HB = (bf16_t*)(ws + mk::WS_HID);
        const int row0 = u.pm * BM + wr * 64 + fr, col0 = u.pc * 128 + wc * 32 + 8 * fq;
        float rsv[2][4], wv[2][4];
#pragma unroll
        for (int ai = 0; ai < 2; ++ai)
#pragma unroll
            for (int m = 0; m < 4; ++m) { rsv[ai][m] = rowrs[row0 + ai * HALF + m * 16]; wv[ai][m] = roww[row0 + ai * HALF + m * 16]; }
#pragma unroll
        for (int ai = 0; ai < 2; ++ai)
#pragma unroll
            for (int m = 0; m < 4; ++m) {
                const int row = row0 + ai * HALF + m * 16; const float rs = rsv[ai][m], w = wv[ai][m];
                f32x4 g0 = acc[ai][0][m][0] * rs, g1 = acc[ai][0][m][1] * rs; const f32x4 u0 = acc[ai][1][m][0] * (rs * w), u1 = acc[ai][1][m][1] * (rs * w);
#pragma unroll
                for (int i = 0; i < 4; ++i) { g0[i] = fast_silu(g0[i]) * u0[i]; g1[i] = fast_silu(g1[i]) * u1[i]; }
                store8(R_, ws, HB + (size_t)row * 256 + col0, g0, g1);
            }
    }
};
template <class Epi, class Sched, bool ALIGN_EPI = false, bool SP2 = false, bool GATHER = false>
__device__ __forceinline__ void gemm_phase(PG8_LAS unsigned char* lds, const Gemm g, const Sched& S, const Epi& E, const int wave_id, const int* rowidx = nullptr) {
    static_assert(!GATHER || SP2, "GATHER is implemented for the SP2 loop only");
    int tid_ = wave_id * 64 + mk::lane_id(); asm volatile("" : "+v"(tid_));
    const int tid = tid_, wid = __builtin_amdgcn_readfirstlane(tid >> 6), lane = tid & 63, wr = wid >> 2, wc = wid & 3, fr = lane & 15, fq = lane >> 4;
    int K_ = g.K; asm volatile("" : "+s"(K_)); const int K = K_, nt = K / BK;
    unsigned voffA[2], voffB[2]; int gR[2], gC[2];
#pragma unroll
    for (int i = 0; i < 2; ++i) { int R, C; stage_rc(tid * 16 + i * 8192, R, C); const int Rb = Epi::PERM ? ((R & ~31) + perm32(R & 31)) : R; gR[i] = R; gC[i] = C;
        voffA[i] = (unsigned)(R * K + C) * 2u; voffB[i] = (unsigned)(Rb * K + C) * 2u; }
    unsigned cvo[2][2], nvo[2][2];
#define PG8_GVO(dst, u) do { _Pragma("unroll") for (int h_ = 0; h_ < 2; ++h_) _Pragma("unroll") for (int i_ = 0; i_ < 2; ++i_) \
        dst[h_][i_] = (unsigned)(rowidx[(u).pm * BM + h_ * HALF + gR[i_]] * K + gC[i_]) * 2u; } while (0)
    const size_t kstep = (size_t)(BK * 2);
    const size_t hstep = (size_t)HALF * K * 2;
    const size_t hstepA = GATHER ? 0 : hstep;
    const size_t tstep = 2 * hstep;
    const unsigned ldsw = (unsigned)wid * 1024u;
    const int aoff = lds_byte(wr * 64 + fr, fq * 8), boff = lds_byte(wc * 32 + fr, fq * 8);
#define PG8_SA(b, h) (((b) * 2 + (h)) * HTB)
#define PG8_SB(b, h) ((4 + (b) * 2 + (h)) * HTB)
#define PG8_STAGE(bufoff, gbase, voff) do { _Pragma("unroll") for (int _i = 0; _i < 2; ++_i) \
        __builtin_amdgcn_global_load_lds((const unsigned*)((const char*)(gbase) + (voff)[_i]), (PG8_LAS unsigned*)(lds + (bufoff) + ldsw + _i * 8192), 16, 0, 0); } while (0)
#define PG8_LDA(dst, b, h) do { _Pragma("unroll") for (int m = 0; m < 4; ++m) _Pragma("unroll") for (int k = 0; k < 2; ++k) dst[m][k] = *(const PG8_LAS bf16x8*)(lds + PG8_SA(b, h) + aoff + m * 2048 + k * 1024); } while (0)
#define PG8_LDB(dst, b, h) do { _Pragma("unroll") for (int n = 0; n < 2; ++n) _Pragma("unroll") for (int k = 0; k < 2; ++k) dst[n][k] = *(const PG8_LAS bf16x8*)(lds + PG8_SB(b, h) + boff + n * 2048 + k * 1024); } while (0)
#define PG8_MMA(ai, bj, At, Bt) do { __builtin_amdgcn_s_setprio(1); _Pragma("unroll") for (int m = 0; m < 4; ++m) _Pragma("unroll") for (int n = 0; n < 2; ++n) _Pragma("unroll") for (int k = 0; k < 2; ++k) \
        acc[ai][bj][m][n] = __builtin_amdgcn_mfma_f32_16x16x32_bf16(Bt[n][k], At[m][k], acc[ai][bj][m][n], 0, 0, 0); __builtin_amdgcn_s_setprio(0); } while (0)
#define PG8_WAIT_V(n) asm volatile("s_waitcnt vmcnt(" #n ")" ::: "memory")
#define PG8_WAIT_L(n) asm volatile("s_waitcnt lgkmcnt(" #n ")" ::: "memory")
#define PG8_BAR __builtin_amdgcn_s_barrier()
#define PG8_SCHED __builtin_amdgcn_sched_barrier(0)
    Unit cur, nxt; int ui = 0;
    if (!S.next(0, cur)) return;
    f32x4 acc[2][2][4][2];
#pragma unroll
    for (int a = 0; a < 2; ++a)
#pragma unroll
        for (int b = 0; b < 2; ++b)
#pragma unroll
            for (int m = 0; m < 4; ++m)
#pragma unroll
                for (int n = 0; n < 2; ++n) acc[a][b][m][n] = (f32x4){0.f, 0.f, 0.f, 0.f};
    bf16x8 At[4][2], B0[2][2], B1[2][2];
    const char* cA = (const char*)g.A + (GATHER ? 0 : (size_t)cur.pm * tstep); const char* cB = (const char*)g.Bt + (size_t)cur.pn * tstep;
    S.a_ready(cur);
    if constexpr (GATHER) { PG8_GVO(cvo, cur); } else { cvo[0][0] = cvo[1][0] = voffA[0]; cvo[0][1] = cvo[1][1] = voffA[1]; }
    if constexpr (SP2) {
        PG8_STAGE(PG8_SB(0, 0), cB, voffB); PG8_STAGE(PG8_SB(0, 1), cB + hstep, voffB); PG8_STAGE(PG8_SA(0, 0), cA, cvo[0]); PG8_STAGE(PG8_SA(0, 1), cA + hstepA, cvo[1]);
        if (wr == 1) PG8_BAR;
        PG8_WAIT_V(2); PG8_BAR;
        PG8_STAGE(PG8_SB(1, 0), cB + kstep, voffB); PG8_STAGE(PG8_SA(1, 0), cA + kstep, cvo[0]); PG8_STAGE(PG8_SB(1, 1), cB + hstep + kstep, voffB);
        PG8_WAIT_V(6); PG8_BAR;
    } else {
        PG8_STAGE(PG8_SB(0, 0), cB, voffB); PG8_STAGE(PG8_SA(0, 0), cA, voffA); PG8_STAGE(PG8_SB(0, 1), cB + hstep, voffB); PG8_STAGE(PG8_SA(0, 1), cA + hstep, voffA);
        if (wr == 1) PG8_BAR;
        PG8_WAIT_V(4); PG8_BAR;
        PG8_STAGE(PG8_SB(1, 0), cB + kstep, voffB); PG8_STAGE(PG8_SA(1, 0), cA + kstep, voffA); PG8_STAGE(PG8_SB(1, 1), cB + hstep + kstep, voffB);
        PG8_WAIT_V(6); PG8_BAR;
    }
    for (;;) {
        const bool has_next = S.next(ui + 1, nxt);
        const char* nA = (has_next && !GATHER) ? (const char*)g.A + (size_t)nxt.pm * tstep : cA; const char* nB = has_next ? (const char*)g.Bt + (size_t)nxt.pn * tstep : cB;
        if constexpr (GATHER) { if (has_next) { PG8_GVO(nvo, nxt); } else { nvo[0][0] = cvo[0][0]; nvo[0][1] = cvo[0][1]; nvo[1][0] = cvo[1][0]; nvo[1][1] = cvo[1][1]; } }
        else { nvo[0][0] = nvo[1][0] = voffA[0]; nvo[0][1] = nvo[1][1] = voffA[1]; }
        for (int t = 0; t < nt; t += 2) {
            const bool last = (t == nt - 2);
            const char* a1 = cA + (size_t)(t + 1) * kstep;
            const char* a2 = last ? nA : cA + (size_t)(t + 2) * kstep; const char* b2 = last ? nB : cB + (size_t)(t + 2) * kstep;
            const char* a3 = a2 + kstep; const char* b3 = b2 + kstep;
            if (last && has_next) S.a_ready(nxt);
            unsigned vo0[2], vo1[2];
            vo0[0] = last ? nvo[0][0] : cvo[0][0]; vo0[1] = last ? nvo[0][1] : cvo[0][1]; vo1[0] = last ? nvo[1][0] : cvo[1][0]; vo1[1] = last ? nvo[1][1] : cvo[1][1];
            if constexpr (SP2) {
            PG8_LDB(B0, 0, 0); PG8_LDB(B1, 0, 1); PG8_SCHED; PG8_LDA(At, 0, 0); PG8_STAGE(PG8_SA(1, 1), a1 + hstepA, cvo[1]);
            PG8_WAIT_V(8); PG8_WAIT_L(0); PG8_BAR; PG8_MMA(0, 0, At, B0); PG8_MMA(0, 1, At, B1); PG8_BAR; PG8_SCHED;
            PG8_LDA(At, 0, 1); PG8_STAGE(PG8_SB(0, 0), b2, voffB); PG8_STAGE(PG8_SB(0, 1), b2 + hstep, voffB); PG8_STAGE(PG8_SA(0, 0), a2, vo0);
            PG8_WAIT_V(8); PG8_WAIT_L(0); PG8_BAR; PG8_MMA(1, 0, At, B0); PG8_MMA(1, 1, At, B1); PG8_BAR; PG8_SCHED;
            PG8_LDB(B0, 1, 0); PG8_LDB(B1, 1, 1); PG8_SCHED; PG8_LDA(At, 1, 0); PG8_STAGE(PG8_SA(0, 1), a2 + hstepA, vo1);
            PG8_WAIT_V(8); PG8_WAIT_L(0); PG8_BAR; PG8_MMA(0, 0, At, B0); PG8_MMA(0, 1, At, B1); PG8_BAR; PG8_SCHED;
            PG8_LDA(At, 1, 1); PG8_STAGE(PG8_SB(1, 0), b3, voffB); PG8_STAGE(PG8_SB(1, 1), b3 + hstep, voffB); PG8_STAGE(PG8_SA(1, 0), a3, vo0);
            PG8_WAIT_V(8); PG8_WAIT_L(0); PG8_BAR; PG8_MMA(1, 0, At, B0); PG8_MMA(1, 1, At, B1); PG8_BAR; PG8_SCHED;
            } else {
            PG8_LDB(B0, 0, 0); PG8_SCHED; PG8_LDA(At, 0, 0); PG8_STAGE(PG8_SA(1, 1), a1 + hstep, voffA);
            PG8_WAIT_L(8); PG8_BAR; PG8_WAIT_L(0); PG8_MMA(0, 0, At, B0); PG8_BAR; PG8_SCHED;
            PG8_LDB(B1, 0, 1); PG8_STAGE(PG8_SB(0, 0), b2, voffB);
            PG8_BAR; PG8_WAIT_L(0); PG8_MMA(0, 1, At, B1); PG8_BAR;
            PG8_LDA(At, 0, 1); PG8_STAGE(PG8_SA(0, 0), a2, voffA);
            PG8_BAR; PG8_WAIT_L(0); PG8_MMA(1, 0, At, B0); PG8_BAR; PG8_SCHED;
            PG8_STAGE(PG8_SB(0, 1), b2 + hstep, voffB);
            PG8_WAIT_V(6); PG8_BAR; PG8_MMA(1, 1, At, B1); PG8_BAR;
            PG8_LDB(B0, 1, 0); PG8_SCHED; PG8_LDA(At, 1, 0); PG8_STAGE(PG8_SA(0, 1), a2 + hstep, voffA);
            PG8_WAIT_L(8); PG8_BAR; PG8_WAIT_L(0); PG8_MMA(0, 0, At, B0); PG8_BAR; PG8_SCHED;
            PG8_LDB(B1, 1, 1); PG8_STAGE(PG8_SB(1, 0), b3, voffB);
            PG8_BAR; PG8_WAIT_L(0); PG8_MMA(0, 1, At, B1); PG8_BAR;
            PG8_LDA(At, 1, 1); PG8_STAGE(PG8_SA(1, 0), a3, voffA);
            PG8_BAR; PG8_WAIT_L(0); PG8_MMA(1, 0, At, B0); PG8_BAR; PG8_SCHED;
            PG8_STAGE(PG8_SB(1, 1), b3 + hstep, voffB);
            PG8_WAIT_V(6); PG8_BAR; PG8_MMA(1, 1, At, B1); PG8_BAR;
            }
        }
        if constexpr (ALIGN_EPI) { if (wr == 0) PG8_BAR; }
        if constexpr (!Epi::AFTER_DRAIN) { E(acc, cur, wr, wc, fr, fq); S.done(cur); }
        if (!has_next) break;
#pragma unroll
        for (int a = 0; a < 2; ++a)
#pragma unroll
            for (int b = 0; b < 2; ++b)
#pragma unroll
                for (int m = 0; m < 4; ++m)
#pragma unroll
                    for (int n = 0; n < 2; ++n) acc[a][b][m][n] = (f32x4){0.f, 0.f, 0.f, 0.f};
        cur = nxt; cA = nA; cB = nB; ++ui;
        cvo[0][0] = nvo[0][0]; cvo[0][1] = nvo[0][1]; cvo[1][0] = nvo[1][0]; cvo[1][1] = nvo[1][1];
        if constexpr (ALIGN_EPI) { if (wr == 1) PG8_BAR; }
    }
    PG8_WAIT_V(0);
    if constexpr (!ALIGN_EPI) { if (wr == 0) PG8_BAR; }
    PG8_BAR;
    if constexpr (Epi::AFTER_DRAIN) { E.fused(acc, cur, wr, wc, fr, fq, lds, wid, lane); S.done(cur); }
#undef PG8_SA
#undef PG8_GVO
#undef PG8_SB
#undef PG8_STAGE
#undef PG8_LDA
#undef PG8_LDB
#undef PG8_MMA
#undef PG8_WAIT_V
#undef PG8_WAIT_L
#undef PG8_BAR
#undef PG8_SCHED
}
}
#ifndef PG8_SP2
#define PG8_SP2 true
#endif
#include <hip/hip_bf16.h>
namespace attn_body {
using bf16=__hip_bfloat16;
using bf16x8=__attribute__((ext_vector_type(8)))short;
using s16x4=__attribute__((ext_vector_type(4)))short;
using f32x16=__attribute__((ext_vector_type(16)))float;
using u32x4=__attribute__((ext_vector_type(4)))unsigned;
using f32x4v=__attribute__((ext_vector_type(4)))float;
constexpr int SEQ=2048,D=64;
constexpr int NW=8,QBLK=32,QB=QBLK*NW,KVBLK=64;
__device__ __forceinline__ int crow(int r,int hi){return (r&3)+8*(r>>2)+4*hi;}
#define SBAR() __builtin_amdgcn_sched_barrier(0)
__device__ __forceinline__ void cmask(f32x16&p0,f32x16&p1,int jb,int qrel,int hi){
  const float NEG=-INFINITY; int kb=64*jb+4*hi;
  #pragma unroll
  for(int r=0;r<16;++r){int kv=kb+(r&3)+8*(r>>2); if(kv>qrel)p0[r]=NEG; if(kv+32>qrel)p1[r]=NEG;}
}
constexpr int NSLOT=3, SLOTB=8192;
constexpr int LDS_K=0, LDS_V=NSLOT*SLOTB, LDS_WS=2*NSLOT*SLOTB, LDS_OST=LDS_WS+NW*64*4, LDS_CL=LDS_OST+NW*4096, LDS_RED=LDS_CL+SEQ*4, LDS_BYTES=LDS_RED+64;
__device__ __forceinline__ void glds16(const void*gsrc,unsigned lds_dst){unsigned keep;
  asm volatile("s_mov_b32 %0, m0\n\ts_mov_b32 m0, %2\n\ts_nop 0\n\tglobal_load_lds_dwordx4 %1, off\n\ts_mov_b32 m0, %0":"=&s"(keep):"v"(gsrc),"s"(lds_dst):"memory");}
__device__ __forceinline__ float max3f(float a,float b,float c){float r;asm("v_max3_f32 %0, %1, %2, %3":"=v"(r):"v"(a),"v"(b),"v"(c));return r;}
__device__ __forceinline__ float max2f(float a,float b){float r;asm("v_max_f32_e32 %0, %1, %2":"=v"(r):"v"(a),"v"(b));return r;}
__device__ __forceinline__ float fadd_s(float a,float b){float r;asm("v_add_f32_e32 %0, %1, %2":"=v"(r):"v"(a),"v"(b));return r;}
__device__ __forceinline__ float fsub_s(float a,float b){float r;asm("v_sub_f32_e32 %0, %1, %2":"=v"(r):"v"(a),"v"(b));return r;}
typedef float f32x2_t __attribute__((ext_vector_type(2))); typedef __bf16 bf16x2_t __attribute__((ext_vector_type(2)));
__device__ __forceinline__ unsigned cvtpk_s(float lo,float hi){f32x2_t v={lo,hi};bf16x2_t b=__builtin_convertvector(v,bf16x2_t);return __builtin_bit_cast(unsigned,b);}
#define WAIT_BAR(N) asm volatile("s_waitcnt vmcnt(" #N ") lgkmcnt(0)\n\ts_barrier":::"memory")

__device__ __forceinline__ void qkt(f32x16&p0,f32x16&p1,const char*Kslot,const bf16x8*qr,const f32x16&negm,int r32,int hi){
  const char*kb=Kslot+hi*1024+r32*16;
  #pragma unroll
  for(int d0=0;d0<4;++d0){
    const bf16x8 b0=*reinterpret_cast<const bf16x8*>(kb+d0*2048);
    const bf16x8 b1=*reinterpret_cast<const bf16x8*>(kb+d0*2048+512);
    if(d0==0){p0=__builtin_amdgcn_mfma_f32_32x32x16_bf16(b0,qr[0],negm,0,0,0);p1=__builtin_amdgcn_mfma_f32_32x32x16_bf16(b1,qr[0],negm,0,0,0);}
    else{p0=__builtin_amdgcn_mfma_f32_32x32x16_bf16(b0,qr[d0],p0,0,0,0);p1=__builtin_amdgcn_mfma_f32_32x32x16_bf16(b1,qr[d0],p1,0,0,0);}}
}
typedef __attribute__((address_space(3))) const char* lds_cptr;
typedef __attribute__((address_space(3))) const float* lds_fptr;
typedef short v4i16_t __attribute__((ext_vector_type(4)));
__device__ __forceinline__ void kload8(bf16x8*kf,lds_cptr kp){
  kf[0]=*(const __attribute__((address_space(3))) bf16x8*)(kp);      kf[1]=*(const __attribute__((address_space(3))) bf16x8*)(kp+512);
  kf[2]=*(const __attribute__((address_space(3))) bf16x8*)(kp+2048); kf[3]=*(const __attribute__((address_space(3))) bf16x8*)(kp+2560);
  kf[4]=*(const __attribute__((address_space(3))) bf16x8*)(kp+4096); kf[5]=*(const __attribute__((address_space(3))) bf16x8*)(kp+4608);
  kf[6]=*(const __attribute__((address_space(3))) bf16x8*)(kp+6144); kf[7]=*(const __attribute__((address_space(3))) bf16x8*)(kp+6656);
}
__device__ __forceinline__ void kload2(bf16x8*kf,lds_cptr kp,int j){ kf[2*j]=*(const __attribute__((address_space(3))) bf16x8*)(kp+j*2048); kf[2*j+1]=*(const __attribute__((address_space(3))) bf16x8*)(kp+j*2048+512); }
__device__ __forceinline__ s16x4 vtr(lds_cptr p){ return __builtin_bit_cast(s16x4,__builtin_amdgcn_ds_read_tr16_b64_v4i16((__attribute__((address_space(3))) v4i16_t*)p)); }
__device__ __forceinline__ float rowmax(const f32x16&p0,const f32x16&p1){
  float a=max3f(p0[0],p0[1],p1[0]),b=max3f(p0[2],p0[3],p1[1]);a=max3f(a,p1[2],p1[3]);
  #pragma unroll
  for(int r=4;r<16;r+=4){a=max3f(a,p0[r],p0[r+1]);b=max3f(b,p0[r+2],p0[r+3]);a=max3f(a,p1[r],p1[r+1]);b=max3f(b,p1[r+2],p1[r+3]);}
  const float m=max2f(a,b);
  auto rr=__builtin_amdgcn_permlane32_swap(__float_as_uint(m),__float_as_uint(m),false,false);
  return max2f(__uint_as_float(rr[0]),__uint_as_float(rr[1]));
}
__device__ __forceinline__ float rowmax_c(const f32x16&p0,const f32x16&p1){
  float a=fmaxf(p0[0],p1[0]);
  #pragma unroll
  for(int r=1;r<16;++r)a=fmaxf(a,fmaxf(p0[r],p1[r]));
  auto rr=__builtin_amdgcn_permlane32_swap(__float_as_uint(a),__float_as_uint(a),false,false);
  return fmaxf(__uint_as_float(rr[0]),__uint_as_float(rr[1]));
}
__device__ __forceinline__ void pv(f32x16*o,int vb,bf16x8 pa0,bf16x8 pa1,bf16x8 pa2,bf16x8 pa3){
  #pragma unroll
  for(int d0=0;d0<2;++d0){s16x4 lo[4],hi[4];
    #pragma unroll
    for(int ks=0;ks<4;++ks){
      asm volatile("ds_read_b64_tr_b16 %0,%1 offset:%c2":"=&v"(lo[ks]):"v"(vb),"i"(d0*4096+ks*1024):"memory");
      asm volatile("ds_read_b64_tr_b16 %0,%1 offset:%c2":"=&v"(hi[ks]):"v"(vb),"i"(d0*4096+ks*1024+512):"memory");}
    asm volatile("s_waitcnt lgkmcnt(0)":::"memory");SBAR();
    #define PK(k) (bf16x8){lo[k][0],lo[k][1],lo[k][2],lo[k][3],hi[k][0],hi[k][1],hi[k][2],hi[k][3]}
    o[d0]=__builtin_amdgcn_mfma_f32_32x32x16_bf16(pa0,PK(0),o[d0],0,0,0);
    o[d0]=__builtin_amdgcn_mfma_f32_32x32x16_bf16(pa1,PK(1),o[d0],0,0,0);
    o[d0]=__builtin_amdgcn_mfma_f32_32x32x16_bf16(pa2,PK(2),o[d0],0,0,0);
    o[d0]=__builtin_amdgcn_mfma_f32_32x32x16_bf16(pa3,PK(3),o[d0],0,0,0);
    #undef PK
  }
}
#define ATTN_STORE16(p,v) mk::wt16(mk::ws_rsrc(wsb),wsb,(p),(v))

__device__ __forceinline__ void fox_scan(int b,int h,const float*cfl,float bias,char*shm,int wv){
  int tid_=wv*64+mk::lane_id(); asm volatile("":"+v"(tid_)); const int tid=tid_,lane=tid&63,wid=tid>>6;
  float*cl=(float*)(shm+LDS_CL); float*red=(float*)(shm+LDS_RED);
  float v[4];
  #pragma unroll
  for(int i=0;i<4;++i){ const float x=cfl[((size_t)b*SEQ+4*tid+i)*8+h]+bias; v[i]=(fminf(x,0.f)-__logf(1.f+__expf(-fabsf(x))))*1.4426950408889634f; }
  v[1]+=v[0];v[2]+=v[1];v[3]+=v[2];
  float inc=v[3];
  #pragma unroll
  for(int o=1;o<64;o<<=1){ const float y=__builtin_bit_cast(float,__builtin_amdgcn_ds_bpermute(((lane-o)&63)*4,__builtin_bit_cast(int,inc))); if(lane>=o)inc+=y; }
  if(lane==63)red[wid]=inc;
  __syncthreads();
  float base=inc-v[3];
  for(int w=0;w<wid;++w)base+=red[w];
  #pragma unroll
  for(int i=0;i<4;++i)cl[4*tid+i]=base+v[i];
  __syncthreads();
}

template<int THRL,int QP,int KP> __device__ __forceinline__ void fox_unit(int b,int h,int qb,const bf16*Q,const bf16*__restrict__ K,const bf16*__restrict__ V,bf16*O,char*shm,int wv,const unsigned char*wsb){
  int tid_=wv*64+mk::lane_id(); asm volatile("":"+v"(tid_)); const int tid=tid_,lane=tid&63,r32=lane&31,hi=lane>>5; const int wid=__builtin_amdgcn_readfirstlane(tid>>6);
  const long rowbase=(long)b*SEQ; const int q0=qb*QB;
  const bf16*Qw=Q+(rowbase+q0+wid*QBLK)*QP+h*D;
  const bf16*Kh=K+rowbase*KP+h*D,*Vh=V+rowbase*KP+h*D;
  const unsigned lds0=(unsigned)(uintptr_t)shm;
  float*wsf=(float*)(shm+LDS_WS)+wid*64;
  const bf16*ksrc=Kh+(long)lane*KP+wid*8;
  const bf16*vsrc=Vh+(long)(16*(wid&3)+(lane>>2))*KP+(wid>>2)*32+(lane&3)*8;
  const unsigned kdst=lds0+LDS_K+wid*1024, vdst=lds0+LDS_V+wid*1024;
  #define DMA_K(t,slot) glds16(ksrc+(long)(t)*KVBLK*KP,(unsigned)__builtin_amdgcn_readfirstlane(kdst+(slot)))
  #define DMA_V(t,slot) glds16(vsrc+(long)(t)*KVBLK*KP,(unsigned)__builtin_amdgcn_readfirstlane(vdst+(slot)))
  const int vb0=(int)(lds0+LDS_V)+((lane>>4)&1)*32+(lane&3)*8+(4*hi+((lane&15)>>2))*64;
  const char*Kbase=shm+LDS_K; bf16x8 kf[8];
  const lds_cptr shm3=(lds_cptr)shm; const lds_cptr kp0=shm3+LDS_K+hi*1024+r32*16; const lds_cptr vp0=shm3+LDS_V+((lane>>4)&1)*32+(lane&3)*8+(4*hi+((lane&15)>>2))*64;
  const lds_fptr clp=(lds_fptr)(shm3+LDS_CL)+4*hi;
  const int NT=(q0+QB)/KVBLK;
  DMA_K(0,0);DMA_V(0,0);DMA_K(1,SLOTB);
  bf16x8 qr[4];
  #pragma unroll
  for(int d0=0;d0<4;++d0)qr[d0]=*reinterpret_cast<const bf16x8*>(&Qw[(long)r32*QP+d0*16+hi*8]);
  const float cq2=((lds_fptr)(shm3+LDS_CL))[q0+wid*QBLK+r32];
  float mhat=0.f,l_reg=0.f;f32x16 o[2];o[0]=f32x16{};o[1]=f32x16{};f32x16 negm;
  #pragma unroll
  for(int r=0;r<16;++r)negm[r]=cq2;
  asm volatile("":"+v"(negm));
  const int qrel=wid*QBLK+r32;
  #define LDF4(p) (*(const __attribute__((address_space(3))) f32x4v*)(p))
  #define CMASK(P0,P1,t) do{int jb_=(t)-(NT-4); if(jb_>=0)cmask(P0,P1,jb_,qrel,hi);}while(0)
  bool resc=false;
  #define START(P0,P1) do{ const float rm=fsub_s(rowmax(P0,P1),cq2); resc=false; \
    { const float dl=rm; mhat=fadd_s(mhat,dl); \
      _Pragma("unroll") for(int r=0;r<16;++r){P0[r]=fsub_s(P0[r],dl);P1[r]=fsub_s(P1[r],dl);} \
      _Pragma("unroll") for(int r=0;r<16;++r)negm[r]=cq2-mhat; asm volatile("":"+v"(negm)); } \
    _Pragma("unroll") for(int g_=0;g_<4;++g_){ const f32x4v k_=LDF4(clp+8*g_); _Pragma("unroll") for(int i_=0;i_<4;++i_)P0[4*g_+i_]=__builtin_amdgcn_exp2f(P0[4*g_+i_]-k_[i_]); } }while(0)
  #define RESC() do{ if(resc){ asm volatile("s_waitcnt lgkmcnt(0)":::"memory"); \
      _Pragma("unroll") for(int d_=0;d_<2;++d_) _Pragma("unroll") for(int r=0;r<16;++r)o[d_][r]*=wsf[crow(r,hi)]; } }while(0)
  f32x16 pA0,pA1,pB0,pB1;
  int sl_prev=0,sl_cur=0,sl_next=SLOTB;
  #define ROT() do{sl_prev=sl_cur;sl_cur=sl_next;sl_next=(sl_next==(NSLOT-1)*SLOTB)?0:sl_next+SLOTB;}while(0)
  DMA_K(2,2*SLOTB);
  WAIT_BAR(3);
  qkt(pA0,pA1,Kbase,qr,negm,r32,hi);asm volatile("s_nop 15\n\ts_nop 7":"+v"(pA0),"+v"(pA1));CMASK(pA0,pA1,0);
  START(pA0,pA1);
  _Pragma("unroll") for(int g_=0;g_<4;++g_){ const f32x4v k_=LDF4(clp+32+8*g_); _Pragma("unroll") for(int i_=0;i_<4;++i_)pA1[4*g_+i_]=__builtin_amdgcn_exp2f(pA1[4*g_+i_]-k_[i_]); }
  WAIT_BAR(0);
  DMA_K(3,0);DMA_V(1,SLOTB);
  ROT();
  kload8(kf,kp0+sl_cur);
  WAIT_BAR(2);
  s16x4 vlo[8],vhi[8]; u32x4 pw0,pw1,pw2,pw3;
  #define PKW(P,B) cvtpk_s(P[B],P[B+1])
  #define PAF(k) __builtin_bit_cast(bf16x8,pw##k)
  #define VFR(i) (bf16x8){vlo[i][0],vlo[i][1],vlo[i][2],vlo[i][3],vhi[i][0],vhi[i][1],vhi[i][2],vhi[i][3]}
  #define PIN(x) asm volatile("":"+v"(x))
  #define MX3(a,b,c) __builtin_fmaxf(__builtin_fmaxf((a),(b)),(c))
  #define GAPA(MF,A0,A1,A2,A3,W0,W1,PW) do{ MF; sacc+=A0; sacc+=A1; sacc+=A2; sacc+=A3; PIN(sacc); W0; W1; PIN(PW); SBAR(); }while(0)
  #define EX(v) __builtin_amdgcn_exp2f(v)
  #define GAPB(MF,X,B,OFFN) do{ const f32x4v kn_=LDF4(cbt_+(OFFN)); MF; X[B]=EX(X[B]-kc_[0]); X[B+1]=EX(X[B+1]-kc_[1]); X[B+2]=EX(X[B+2]-kc_[2]); X[B+3]=EX(X[B+3]-kc_[3]); kc_=kn_; PIN(X); SBAR(); }while(0)
  #define VRD(i) do{ vlo[i]=vtr(vp_+(((i)>>2)*4096+((i)&3)*1024)); vhi[i]=vtr(vp_+(((i)>>2)*4096+((i)&3)*1024+512)); }while(0)
  #define KRD(G,j) do{ if(G){ kload2(kf,kp0+sl_next,j); SBAR(); } }while(0)
  #define STEP(C0,C1,P0,P1,t,GK,GV,GL) do{ SBAR(); \
    const lds_cptr vp_=vp0+sl_prev; const lds_fptr cbt_=clp+64*(t); \
    VRD(0); SBAR(); float sacc=(P0[0]+P0[1]); \
    GAPA(C0=__builtin_amdgcn_mfma_f32_32x32x16_bf16(kf[0],qr[0],negm,0,0,0), P0[2],P0[3],P0[4],P0[5],     pw0[0]=PKW(P0,0), pw0[1]=PKW(P0,2), pw0); \
    VRD(4); SBAR(); GAPA(C1=__builtin_amdgcn_mfma_f32_32x32x16_bf16(kf[1],qr[0],negm,0,0,0), P0[6],P0[7],P0[8],P0[9],     pw0[2]=PKW(P0,4), pw0[3]=PKW(P0,6), pw0); \
    VRD(1); SBAR(); GAPA(C0=__builtin_amdgcn_mfma_f32_32x32x16_bf16(kf[2],qr[1],C0,0,0,0),   P0[10],P0[11],P0[12],P0[13], pw1[0]=PKW(P0,8), pw1[1]=PKW(P0,10), pw1); \
    VRD(5); SBAR(); GAPA(C1=__builtin_amdgcn_mfma_f32_32x32x16_bf16(kf[3],qr[1],C1,0,0,0),   P0[14],P0[15],P1[0],P1[1],   pw1[2]=PKW(P0,12),pw1[3]=PKW(P0,14), pw1); \
    VRD(2); SBAR(); GAPA(C0=__builtin_amdgcn_mfma_f32_32x32x16_bf16(kf[4],qr[2],C0,0,0,0),   P1[2],P1[3],P1[4],P1[5],     pw2[0]=PKW(P1,0), pw2[1]=PKW(P1,2), pw2); \
    VRD(6); SBAR(); GAPA(C1=__builtin_amdgcn_mfma_f32_32x32x16_bf16(kf[5],qr[2],C1,0,0,0),   P1[6],P1[7],P1[8],P1[9],     pw2[2]=PKW(P1,4), pw2[3]=PKW(P1,6), pw2); \
    VRD(3); SBAR(); GAPA(C0=__builtin_amdgcn_mfma_f32_32x32x16_bf16(kf[6],qr[3],C0,0,0,0),   P1[10],P1[11],P1[12],P1[13], pw3[0]=PKW(P1,8), pw3[1]=PKW(P1,10), pw3); \
    VRD(7); SBAR(); GAPA(C1=__builtin_amdgcn_mfma_f32_32x32x16_bf16(kf[7],qr[3],C1,0,0,0),   P1[14],P1[15],0.f,0.f,       pw3[2]=PKW(P1,12),pw3[3]=PKW(P1,14), pw3); \
    l_reg+=sacc; \
    if(GK){DMA_K((t)+3,sl_cur);} if(GV){DMA_V((t)+1,sl_next);} \
    CMASK(C0,C1,t); \
    f32x4v kc_=LDF4(cbt_); \
    { float a=MX3(C0[0],C0[1],C1[0]),b=MX3(C0[2],C0[3],C1[1]); a=MX3(a,C1[2],C1[3]); \
      _Pragma("unroll") for(int r=4;r<16;r+=4){a=MX3(a,C0[r],C0[r+1]);b=MX3(b,C0[r+2],C0[r+3]);a=MX3(a,C1[r],C1[r+1]);b=MX3(b,C1[r+2],C1[r+3]);} \
      float rm=__builtin_fmaxf(a,b); { auto rr=__builtin_amdgcn_permlane32_swap(__float_as_uint(rm),__float_as_uint(rm),false,false); rm=__builtin_fmaxf(__uint_as_float(rr[0]),__uint_as_float(rr[1]))-cq2; } \
      resc=false; \
      if(__builtin_expect(__any(rm>(float)THRL),0)){ const float dl=__builtin_fmaxf(rm,0.f); mhat+=dl; \
        _Pragma("unroll") for(int r=0;r<16;++r){C0[r]-=dl;C1[r]-=dl;} \
        _Pragma("unroll") for(int r=0;r<16;++r)negm[r]=cq2-mhat; asm volatile("":"+v"(negm)); \
        const float f=__builtin_amdgcn_exp2f(-dl); l_reg*=f; if(hi==0)wsf[r32]=f; resc=true; } } \
    SBAR(); \
    GAPB(o[0]=__builtin_amdgcn_mfma_f32_32x32x16_bf16(PAF(0),VFR(0),o[0],0,0,0), C0,0,8); \
    GAPB(o[1]=__builtin_amdgcn_mfma_f32_32x32x16_bf16(PAF(0),VFR(4),o[1],0,0,0), C0,4,16); \
    KRD(GL,0); GAPB(o[0]=__builtin_amdgcn_mfma_f32_32x32x16_bf16(PAF(1),VFR(1),o[0],0,0,0), C0,8,24); \
    KRD(GL,1); GAPB(o[1]=__builtin_amdgcn_mfma_f32_32x32x16_bf16(PAF(1),VFR(5),o[1],0,0,0), C0,12,32); \
    KRD(GL,2); GAPB(o[0]=__builtin_amdgcn_mfma_f32_32x32x16_bf16(PAF(2),VFR(2),o[0],0,0,0), C1,0,40); \
    KRD(GL,3); GAPB(o[1]=__builtin_amdgcn_mfma_f32_32x32x16_bf16(PAF(2),VFR(6),o[1],0,0,0), C1,4,48); \
    GAPB(o[0]=__builtin_amdgcn_mfma_f32_32x32x16_bf16(PAF(3),VFR(3),o[0],0,0,0), C1,8,56); \
    GAPB(o[1]=__builtin_amdgcn_mfma_f32_32x32x16_bf16(PAF(3),VFR(7),o[1],0,0,0), C1,12,0); \
    }while(0)
  int t=1;
  #undef CMASK
  #define CMASK(P0,P1,t) do{}while(0)
  for(;t+5<NT;t+=2){
    STEP(pB0,pB1,pA0,pA1,t,true,true,true);     WAIT_BAR(2); RESC(); ROT();
    STEP(pA0,pA1,pB0,pB1,t+1,true,true,true);   WAIT_BAR(2); RESC(); ROT();
  }
  #undef CMASK
  #define CMASK(P0,P1,t) do{int jb_=(t)-(NT-4); if(jb_>=0)cmask(P0,P1,jb_,qrel,hi);}while(0)
  #define ENDW(tt) do{ if((tt)+3<NT){WAIT_BAR(2);} else if((tt)+2<NT){WAIT_BAR(1);} else {WAIT_BAR(0);} }while(0)
  for(;t+1<NT;t+=2){
    STEP(pB0,pB1,pA0,pA1,t,(t+3<NT),(t+1<NT),(t+1<NT));       ENDW(t);   RESC(); ROT();
    STEP(pA0,pA1,pB0,pB1,t+1,(t+4<NT),(t+2<NT),(t+2<NT));     ENDW(t+1); RESC(); ROT();
  }
  STEP(pB0,pB1,pA0,pA1,NT-1,false,false,false); RESC();
  { float sacc=pB0[0]+pB0[1]; _Pragma("unroll") for(int r=2;r<16;++r)sacc+=pB0[r]; _Pragma("unroll") for(int r=0;r<16;++r)sacc+=pB1[r]; l_reg+=sacc;
    pw0=(u32x4){PKW(pB0,0),PKW(pB0,2),PKW(pB0,4),PKW(pB0,6)};pw1=(u32x4){PKW(pB0,8),PKW(pB0,10),PKW(pB0,12),PKW(pB0,14)};pw2=(u32x4){PKW(pB1,0),PKW(pB1,2),PKW(pB1,4),PKW(pB1,6)};pw3=(u32x4){PKW(pB1,8),PKW(pB1,10),PKW(pB1,12),PKW(pB1,14)};
    SBAR(); pv(o,vb0+sl_cur,PAF(0),PAF(1),PAF(2),PAF(3)); }
  #undef GAPA
  #undef GAPB
  #undef EX
  #undef VRD
  #undef KRD
  #undef STEP
  #undef ENDW
  #undef LDF4
  {auto rr=__builtin_amdgcn_permlane32_swap(__float_as_uint(l_reg),__float_as_uint(l_reg),false,false);l_reg=__uint_as_float(rr[0])+__uint_as_float(rr[1]);}
  if(hi==0)wsf[32+r32]=l_reg;asm volatile("s_waitcnt lgkmcnt(0)":::"memory");
  float rli[16];
  #pragma unroll
  for(int r=0;r<16;++r)rli[r]=__builtin_amdgcn_rcpf(wsf[32+crow(r,hi)]);
  bf16*Ow=O+(rowbase+q0+wid*QBLK)*QP+h*D;
  { bf16*stg=(bf16*)(shm+LDS_OST)+wid*2048;
    #pragma unroll
    for(int r=0;r<16;++r){const int orow=crow(r,hi);
      #pragma unroll
      for(int d0=0;d0<2;++d0)stg[orow*64+d0*32+r32]=__float2bfloat16(o[d0][r]*rli[r]);}
    asm volatile("s_waitcnt lgkmcnt(0)":::"memory");
    #pragma unroll
    for(int i=0;i<4;++i){const int row=i*8+(lane>>3),ch=lane&7; const u32x4 v=*(const u32x4*)(stg+row*64+ch*8); ATTN_STORE16(Ow+(long)row*QP+ch*8,v);} }
  asm volatile("s_waitcnt lgkmcnt(0)\n\ts_barrier":::"memory");
  #undef DMA_K
  #undef DMA_V
  #undef CMASK
  #undef START
  #undef RESC
  #undef ROT
}

template<int QP,int KP> __device__ __forceinline__ void swa_unit(int b,int kvh,int qb,const bf16*Q,const bf16*__restrict__ K,const bf16*__restrict__ V,bf16*O,const float*sinks,char*shm,int wv,const unsigned char*wsb){
  int tid_=wv*64+mk::lane_id(); asm volatile("":"+v"(tid_)); const int tid=tid_,lane=tid&63,r32=lane&31,hi=lane>>5; const int wid=__builtin_amdgcn_readfirstlane(tid>>6);
  const long rowbase=(long)b*SEQ; const int q0=qb*64; const int head=kvh*4+(wid>>1); const int qw=q0+32*(wid&1);
  const bf16*Qw=Q+(rowbase+qw)*QP+head*D;
  const bf16*Kh=K+rowbase*KP+kvh*D,*Vh=V+rowbase*KP+kvh*D;
  const unsigned lds0=(unsigned)(uintptr_t)shm;
  float*wsf=(float*)(shm+LDS_WS)+wid*64;
  const bf16*ksrc=Kh+(long)lane*KP+wid*8;
  const bf16*vsrc=Vh+(long)(16*(wid&3)+(lane>>2))*KP+(wid>>2)*32+(lane&3)*8;
  const unsigned kdst=lds0+LDS_K+wid*1024, vdst=lds0+LDS_V+wid*1024;
  const int vb0=(int)(lds0+LDS_V)+((lane>>4)&1)*32+(lane&3)*8+(4*hi+((lane&15)>>2))*64;
  const int tlo=qb>=2?qb-2:0, NT=qb-tlo+1;
  for(int j=0;j<NT;++j){ glds16(ksrc+(long)(tlo+j)*KVBLK*KP,(unsigned)__builtin_amdgcn_readfirstlane(kdst+j*SLOTB)); glds16(vsrc+(long)(tlo+j)*KVBLK*KP,(unsigned)__builtin_amdgcn_readfirstlane(vdst+j*SLOTB)); }
  bf16x8 qr[4];
  #pragma unroll
  for(int d0=0;d0<4;++d0)qr[d0]=*reinterpret_cast<const bf16x8*>(&Qw[(long)r32*QP+d0*16+hi*8]);
  float mhat=sinks[head]*1.4426950408889634f, l_reg=(hi==0)?1.f:0.f; f32x16 o[2];o[0]=f32x16{};o[1]=f32x16{};
  WAIT_BAR(0);
  const int qabs=qw+r32;
  for(int j=0;j<NT;++j){
    f32x16 negm;
    #pragma unroll
    for(int r=0;r<16;++r)negm[r]=-mhat;
    f32x16 p0,p1; qkt(p0,p1,shm+LDS_K+j*SLOTB,qr,negm,r32,hi);
    const int kb=64*(tlo+j)+4*hi;
    #pragma unroll
    for(int r=0;r<16;++r){ const int kv=kb+(r&3)+8*(r>>2); if(kv>qabs||kv<=qabs-128)p0[r]=-INFINITY; if(kv+32>qabs||kv+32<=qabs-128)p1[r]=-INFINITY; }
    const float rm=rowmax_c(p0,p1);
    if(__any(rm>0.f)){ const float dl=fmaxf(rm,0.f); mhat+=dl;
      #pragma unroll
      for(int r=0;r<16;++r){p0[r]-=dl;p1[r]-=dl;}
      const float f=__builtin_amdgcn_exp2f(-dl); l_reg*=f; if(hi==0)wsf[r32]=f;
      asm volatile("s_waitcnt lgkmcnt(0)":::"memory");
      #pragma unroll
      for(int d_=0;d_<2;++d_)
        #pragma unroll
        for(int r=0;r<16;++r)o[d_][r]*=wsf[crow(r,hi)];
    }
    float sacc=0.f;
    #pragma unroll
    for(int r=0;r<16;++r){p0[r]=__builtin_amdgcn_exp2f(p0[r]);p1[r]=__builtin_amdgcn_exp2f(p1[r]);sacc+=p0[r]+p1[r];}
    l_reg+=sacc;
    u32x4 pw0,pw1,pw2,pw3;
    pw0=(u32x4){cvtpk_s(p0[0],p0[1]),cvtpk_s(p0[2],p0[3]),cvtpk_s(p0[4],p0[5]),cvtpk_s(p0[6],p0[7])};
    pw1=(u32x4){cvtpk_s(p0[8],p0[9]),cvtpk_s(p0[10],p0[11]),cvtpk_s(p0[12],p0[13]),cvtpk_s(p0[14],p0[15])};
    pw2=(u32x4){cvtpk_s(p1[0],p1[1]),cvtpk_s(p1[2],p1[3]),cvtpk_s(p1[4],p1[5]),cvtpk_s(p1[6],p1[7])};
    pw3=(u32x4){cvtpk_s(p1[8],p1[9]),cvtpk_s(p1[10],p1[11]),cvtpk_s(p1[12],p1[13]),cvtpk_s(p1[14],p1[15])};
    SBAR(); pv(o,vb0+j*SLOTB,__builtin_bit_cast(bf16x8,pw0),__builtin_bit_cast(bf16x8,pw1),__builtin_bit_cast(bf16x8,pw2),__builtin_bit_cast(bf16x8,pw3));
  }
  {auto rr=__builtin_amdgcn_permlane32_swap(__float_as_uint(l_reg),__float_as_uint(l_reg),false,false);l_reg=__uint_as_float(rr[0])+__uint_as_float(rr[1]);}
  if(hi==0)wsf[32+r32]=l_reg;asm volatile("s_waitcnt lgkmcnt(0)":::"memory");
  float rli[16];
  #pragma unroll
  for(int r=0;r<16;++r)rli[r]=__builtin_amdgcn_rcpf(wsf[32+crow(r,hi)]);
  bf16*Ow=O+(rowbase+qw)*QP+head*D;
  { bf16*stg=(bf16*)(shm+LDS_OST)+wid*2048;
    #pragma unroll
    for(int r=0;r<16;++r){const int orow=crow(r,hi);
      #pragma unroll
      for(int d0=0;d0<2;++d0)stg[orow*64+d0*32+r32]=__float2bfloat16(o[d0][r]*rli[r]);}
    asm volatile("s_waitcnt lgkmcnt(0)":::"memory");
    #pragma unroll
    for(int i=0;i<4;++i){const int row=i*8+(lane>>3),ch=lane&7; const u32x4 v=*(const u32x4*)(stg+row*64+ch*8); ATTN_STORE16(Ow+(long)row*QP+ch*8,v);} }
  asm volatile("s_waitcnt lgkmcnt(0)\n\ts_barrier":::"memory");
}
#undef SBAR
#undef WAIT_BAR
}
namespace mk {
#define GAS __attribute__((address_space(1)))
#define LAS __attribute__((address_space(3)))
typedef unsigned short bf16;
typedef unsigned v4u __attribute__((ext_vector_type(4)));
typedef unsigned v2u __attribute__((ext_vector_type(2)));
typedef float f32x4 __attribute__((ext_vector_type(4)));
typedef float f32x2 __attribute__((ext_vector_type(2)));
typedef float f32x16 __attribute__((ext_vector_type(16)));
typedef short bf16x8 __attribute__((ext_vector_type(8)));
typedef GAS unsigned gu32;
typedef GAS unsigned long long gu64;
#define RLX_AGENT __ATOMIC_RELAXED, __HIP_MEMORY_SCOPE_AGENT
#define LDS_WAIT() asm volatile("s_waitcnt lgkmcnt(0)" ::: "memory")
#define VM_WAIT() asm volatile("s_waitcnt vmcnt(0)" ::: "memory")
using pg8::cvt_pk_bf16; using pg8::bf_lo; using pg8::bf_hi;
__device__ __forceinline__ unsigned pk2(float lo, float hi) { return cvt_pk_bf16(lo, hi); }

#define XB_TMO      128
#define XB_XCNT(j)  (256  + 64 * (j))
#define XB_XSUB(j)  (1280 + 64 * (j))
#define XB_XGEN(j)  (2304 + 64 * (j))
#define XB_TOP      3328
#define XB_TOPGEN   3392
#define XCD_BAR_WORDS 3456
#define XB_SPIN_CAP (1u << 18)

__device__ __forceinline__ unsigned xb_ld(unsigned* p)              { return __hip_atomic_load(p, __ATOMIC_RELAXED, __HIP_MEMORY_SCOPE_AGENT); }
__device__ __forceinline__ unsigned xb_add(unsigned* p, unsigned v) { return __hip_atomic_fetch_add(p, v, __ATOMIC_RELAXED, __HIP_MEMORY_SCOPE_AGENT); }
__device__ __forceinline__ unsigned xb_xcc_id() { return (unsigned)__builtin_amdgcn_s_getreg((3 << 11) | 20) & 0xFu; }
#define XB_SPIN(cond, bar) do { unsigned _sp = 0; while (cond) { __builtin_amdgcn_s_sleep(1); \
    if ((++_sp & 255u) == 0u) { if (xb_ld(&(bar)[XB_TMO])) break; if (_sp > XB_SPIN_CAP) { atomicAdd(&(bar)[XB_TMO], 1u); break; } } } } while (0)

struct XcdBarrier {
    unsigned* bar; unsigned x;
    volatile LAS unsigned* st;
};

__device__ __forceinline__ XcdBarrier xcd_barrier_post(unsigned* bar, volatile LAS unsigned* st) {
    XcdBarrier b; b.bar = bar; b.x = xb_xcc_id(); b.st = st;
    if (threadIdx.x == 0) (void)xb_add(&bar[XB_XCNT(b.x)], 1u);
    return b;
}
__device__ __forceinline__ void xcd_barrier_complete(unsigned* bar, unsigned x, unsigned& nloc, unsigned& nx) {
    const unsigned G = gridDim.x * gridDim.y * gridDim.z;
    unsigned sum, cnt, mine, sp = 0u;
    for (;;) {
        sum = 0u; cnt = 0u; mine = 0u;
#pragma unroll
        for (unsigned j = 0; j < 16; ++j) { const unsigned c = xb_ld(&bar[XB_XCNT(j)]); sum += c; cnt += (c > 0u) ? 1u : 0u; mine = (j == x) ? c : mine; }
        if (sum == G) break;
        __builtin_amdgcn_s_sleep(1);
        if ((++sp & 255u) == 0u) { if (xb_ld(&bar[XB_TMO])) break; if (sp > XB_SPIN_CAP) { atomicAdd(&bar[XB_TMO], 1u); break; } }
    }
    nloc = mine > 0u ? mine : 1u; nx = cnt > 0u ? cnt : 1u;
}

__device__ __forceinline__ void xcd_barrier(const XcdBarrier& b) {
    asm volatile("s_waitcnt vmcnt(0)" ::: "memory");
    __syncthreads();
    if (threadIdx.x == 0) {
        unsigned* bar = b.bar;
        __builtin_amdgcn_s_waitcnt(0);
        unsigned nloc = b.st[0], nx = b.st[1];
        if (nloc == 0u) { xcd_barrier_complete(bar, b.x, nloc, nx); b.st[0] = nloc; b.st[1] = nx; }
        const unsigned old = xb_add(&bar[XB_XSUB(b.x)], 1u);
        const unsigned gen = old / nloc;
        if (old + 1u == (gen + 1u) * nloc) {
            __builtin_amdgcn_fence(__ATOMIC_RELEASE, "agent");
            asm volatile("s_waitcnt vmcnt(0)" ::: "memory");
            const unsigned og = xb_add(&bar[XB_TOP], 1u);
            const unsigned tg = og / nx;
            if (og + 1u == (tg + 1u) * nx) xb_add(&bar[XB_TOPGEN], 1u);
            else XB_SPIN(xb_ld(&bar[XB_TOPGEN]) == tg, bar);
            __builtin_amdgcn_fence(__ATOMIC_ACQUIRE, "agent");
            xb_add(&bar[XB_XGEN(b.x)], 1u);
            asm volatile("s_waitcnt vmcnt(0)" ::: "memory");
        } else {
            XB_SPIN(xb_ld(&bar[XB_XGEN(b.x)]) == gen, bar);
            __builtin_amdgcn_fence(__ATOMIC_ACQUIRE, "agent");
            asm volatile("s_waitcnt vmcnt(0)" ::: "memory");
        }
    }
    __syncthreads();
}


struct Args { const float* in[31]; float* out; unsigned char* ws; const float* prep_src; int ph_lo, ph_hi, flags, li, prep_layer, pad; };

__device__ __forceinline__ float wave_sum(float v) { return wave_sum64(v); }

struct TItem { const float* src; bf16* dst; const float* gs; int ld, k0, c0, dstK, drow0; };
__device__ __forceinline__ void titem_load(const TItem& d, float (&r)[32], int lane) {
    const float* p = d.src + (size_t)(d.k0 + (lane >> 5)) * d.ld + d.c0 + (lane & 31);
#pragma unroll
    for (int i = 0; i < 32; ++i) r[i] = __builtin_nontemporal_load(p + (size_t)(2 * i) * d.ld);
}
__device__ __forceinline__ void titem_finish(const TItem& d, const float (&r)[32], LAS float* scr, int lane, const unsigned char* ws) {
    const __amdgpu_buffer_rsrc_t R_ = ws_rsrc(ws);
#pragma unroll
    for (int i = 0; i < 32; ++i) scr[(2 * i + (lane >> 5)) * 33 + (lane & 31)] = r[i];
    const int c = lane & 7;
    f32x4 g0 = {1.f, 1.f, 1.f, 1.f}, g1 = {1.f, 1.f, 1.f, 1.f};
    if (d.gs) { g0 = *(const f32x4*)(d.gs + d.k0 + 8 * c); g1 = *(const f32x4*)(d.gs + d.k0 + 8 * c + 4); }
    LDS_WAIT(); asm volatile("" ::: "memory");
#pragma unroll
    for (int j = 0; j < 4; ++j) { const int n = (lane >> 3) + 8 * j; const LAS float* s = scr + (8 * c) * 33 + n;
        v4u o; o.x = pk2(s[0 * 33] * g0.x, s[1 * 33] * g0.y); o.y = pk2(s[2 * 33] * g0.z, s[3 * 33] * g0.w); o.z = pk2(s[4 * 33] * g1.x, s[5 * 33] * g1.y); o.w = pk2(s[6 * 33] * g1.z, s[7 * 33] * g1.w);
        wt16c(R_, ws, d.dst + (size_t)(d.drow0 + n) * d.dstK + d.k0 + 8 * c, o); }
    LDS_WAIT(); asm volatile("" ::: "memory");
}
__device__ __forceinline__ int head_perm(int c) { const int t = c & ~255, l = c & 255; return t + 128 * ((l >> 5) & 1) + 32 * (l >> 6) + (l & 31); }

__device__ __forceinline__ void row_prep(const float* src, bf16* hb, float* ssq, int lane, f32x4 (&v)[4]) {
    const GAS f32x4* xr = (const GAS f32x4*)src + 4 * lane;
    float s = 0.f;
#pragma unroll
    for (int j = 0; j < 4; ++j) { v[j] = xr[j]; s += (v[j].x * v[j].x + v[j].y * v[j].y) + (v[j].z * v[j].z + v[j].w * v[j].w); }
    v4u o0, o1; o0.x = pk2(v[0].x, v[0].y); o0.y = pk2(v[0].z, v[0].w); o0.z = pk2(v[1].x, v[1].y); o0.w = pk2(v[1].z, v[1].w);
    o1.x = pk2(v[2].x, v[2].y); o1.y = pk2(v[2].z, v[2].w); o1.z = pk2(v[3].x, v[3].y); o1.w = pk2(v[3].z, v[3].w);
    GAS v4u* o = (GAS v4u*)hb + 2 * lane; o[0] = o0; o[1] = o1;
    s += xor_lane<1>(s); s += xor_lane<2>(s);
    if ((lane & 3) == 0) ssq[lane >> 2] = s;
}

struct Frame {
    LAS unsigned char* lds; gu32* ctl; unsigned char* ws;
    int tid, lane, wave, vcu, G;
    float* out;
};
#define WSP(T_, off) ((T_*)(F.ws + (off)))
#define IN(i) (in_ptr(i))

constexpr int I_IN0 = 16 * 80, I_SQ = 16 * 32, I_IN1 = 16 * 56, I_PP = 4 * 32, I_MG = 32 * 16 * 8, I_MD = 32 * 4 * 32;
constexpr int Q_IN0 = 0, Q_OUT0 = Q_IN0 + I_IN0, Q_PP0 = Q_OUT0 + I_SQ, Q_G0 = Q_PP0 + I_PP, Q_U0 = Q_G0 + I_MG, Q_D0 = Q_U0 + I_MG, Q_PG0 = Q_D0 + I_MD,
              Q_IN1 = Q_PG0 + I_SQ, Q_OUT1 = Q_IN1 + I_IN1, Q_PP1 = Q_OUT1 + I_SQ, Q_G1 = Q_PP1 + I_PP, Q_U1 = Q_G1 + I_MG, Q_D1 = Q_U1 + I_MG, Q_PG1 = Q_D1 + I_MD, Q_END = Q_PG1 + I_SQ;
__device__ __forceinline__ int q_deadline(int p) {
    switch (p) { case 0: return 0; case 1: case 2: return Q_OUT0; case 3: case 4: return Q_PP0; case 5: return Q_G0; case 6: return Q_D0; case 7: case 8: return Q_PG0; case 9: return Q_IN1;
                 case 10: case 11: return Q_OUT1; case 12: case 13: return Q_PP1; case 14: return Q_G1; case 15: return Q_D1; case 16: case 17: return Q_PG1; default: return Q_END; }
}
__device__ __forceinline__ TItem q_decode(Frame& F, int qi) {
    const int l = qi >= Q_IN1; const int r0 = qi - (l ? Q_IN1 : 0);
    const int iin = l ? I_IN1 : I_IN0;
    TItem d;
    if (r0 < iin) {
        if (!l) { const int kb = r0 / 80, nb = r0 % 80, c = nb * 32; const int dr = (c >= 1024 && c < 2048) ? head_perm(c) : c; d = TItem{IN(3), WSP(bf16, WS_WIN0), IN(2), EVEN_IN, kb * 64, c, 1024, dr}; }
        else { const int kb = r0 / 56, nb = r0 % 56, c = nb * 32; int dr;
            if (c < 768) dr = head_perm(c); else if (c < 1280) { const int cc = c - 768; dr = (3 + cc / 128) * 256 + (cc & 127); } else { const int cc = c - 1280; dr = (3 + cc / 128) * 256 + 128 + (cc & 127); }
            d = TItem{IN(12), WSP(bf16, WS_WIN1), IN(2) + 1024, ODD_IN, kb * 64, c, 1024, dr}; }
        return d; }
    int r = r0 - iin;
    if (r < I_SQ) { const int kb = r / 32, nb = r % 32; return TItem{l ? IN(19) : IN(11), WSP(bf16, l ? WS_WOUT1 : WS_WOUT0), nullptr, 1024, kb * 64, nb * 32, 1024, nb * 32}; }
    r -= I_SQ;
    if (r < I_PP) { const int kb = r / 32, nb = r % 32; return TItem{IN(28) + (size_t)l * 256 * 1024, WSP(bf16, WS_WPP) + (size_t)l * 1024 * 256, nullptr, 1024, kb * 64, nb * 32, 256, nb * 32}; }
    r -= I_PP;
    if (r < 2 * I_MG) { const int up = r >= I_MG; if (up) r -= I_MG; const int le = l * 32 + r / 128, q = r % 128, kb = q / 8, nb = q % 8, fc = nb * 32;
        return TItem{(up ? IN(26) : IN(25)) + (size_t)le * 1024 * 256, WSP(bf16, WS_W1) + (size_t)le * 512 * 1024, IN(20) + l * 1024, 256, kb * 64, fc, 1024, 256 * (fc >> 7) + 128 * up + (fc & 127)}; }
    r -= 2 * I_MG;
    if (r < I_MD) { const int le = l * 32 + r / 128, q = r % 128, kb = q / 32, nb = q % 32; return TItem{IN(27) + (size_t)le * 256 * 1024, WSP(bf16, WS_W2) + (size_t)le * 1024 * 256, nullptr, 1024, kb * 64, nb * 32, 256, nb * 32}; }
    r -= I_MD;
    { const int kb = r / 32, nb = r % 32; return TItem{IN(30) + (size_t)l * 1024 * 1024, WSP(bf16, WS_WPG) + (size_t)l * 1024 * 1024, IN(29) + l * 1024, 1024, kb * 64, nb * 32, 1024, nb * 32}; }
}
__device__ __forceinline__ void q_run(Frame& F, int lo, int hi, int widx, int wn) {
    LAS float* scr = (LAS float*)(F.lds + F.wave * 16384);
    const int lane = F.lane;
    int it = lo + widx; TItem da, db; float ra[32], rb[32];
    if (it < hi) { da = q_decode(F, it); titem_load(da, ra, lane); }
    while (it < hi) {
        int itn = it + wn;
        if (itn < hi) { db = q_decode(F, itn); titem_load(db, rb, lane); }
        titem_finish(da, ra, scr, lane, F.ws);
        it = itn; if (it >= hi) break;
        itn = it + wn;
        if (itn < hi) { da = q_decode(F, itn); titem_load(da, ra, lane); }
        titem_finish(db, rb, scr, lane, F.ws);
        it = itn;
    }
}
__device__ __forceinline__ void q_seam(Frame& F, int k, int idle_i, int idle_n) {
    constexpr int R1 = Q_OUT0 + 8000, R6 = Q_D0 + 7168, R10 = Q_U1 + 3072;
    static_assert(R1 < Q_D0 && R6 < Q_U1 && R10 < Q_D1, "conversion schedule");
    const int gw = F.vcu * NWAVES + F.wave, NGW = F.G * NWAVES;
    int lo = 0, hi = 0; bool idle_only = false;
    switch (k) { case 0: lo = 0; hi = Q_OUT0; break; case 1: lo = Q_OUT0; hi = R1; idle_only = true; break; case 5: lo = R1; hi = Q_D0; break; case 6: lo = Q_D0; hi = R6; idle_only = true; break;
                 case 7: lo = R6; hi = Q_U1; idle_only = true; break; case 10: lo = Q_U1; hi = R10; idle_only = true; break; case 14: lo = R10; hi = Q_D1; break; case 15: lo = Q_D1; hi = Q_END; idle_only = true; break; default: return; }
    int widx = gw, wn = NGW; bool mine = true;
    if (idle_only && idle_n > 0) { mine = idle_i >= 0; widx = idle_i * NWAVES + F.wave; wn = idle_n * NWAVES; }
    if (!mine) return;
    q_run(F, lo, hi, widx, wn);
}

__device__ __forceinline__ void p0_weights(Frame& F) {
    const int gw = F.vcu * NWAVES + F.wave, NGW = F.G * NWAVES, lane = F.lane;
    { const size_t n4 = (size_t)2 * T * DPLE / 4; const GAS f32x4* src = (const GAS f32x4*)IN(1); GAS v2u* dst = (GAS v2u*)WSP(bf16, WS_PB);
      for (size_t i = (size_t)gw * 64 + lane; i < n4; i += (size_t)NGW * 64) { const f32x4 v = __builtin_nontemporal_load(src + i); v2u o; o.x = pk2(v.x, v.y); o.y = pk2(v.z, v.w); dst[i] = o; } }
    { bf16* RH = WSP(bf16, WS_RW); bf16* RL = RH + 2 * 48 * 1024;
      for (int i = gw * 64 + lane; i < 2 * 48 * 1024; i += NGW * 64) { const int l = i / (48 * 1024), n = (i / 1024) % 48, k = i % 1024; float v = 0.f;
          if (n < 4) v = IN(21)[((size_t)l * 1024 + k) * 4 + n]; else if (n < 36) { const int g = (n - 4) >> 3, j = (n - 4) & 7; v = IN(23)[(((size_t)l * 4 + g) * 1024 + k) * 8 + j]; }
          v *= IN(20)[l * 1024 + k];
          const unsigned h = pk2(v, 0.f) & 0xffffu; const float hf = __builtin_bit_cast(float, h << 16);
          RH[i] = (bf16)h; RL[i] = (bf16)(pk2(v - hf, 0.f) & 0xffffu); }
      float* RB = WSP(float, WS_RB);
      if (gw == 0) for (int i = lane; i < 96; i += 64) { const int l = i / 48, n = i % 48; RB[i] = n < 4 ? IN(22)[l * 4 + n] : (n < 36 ? IN(24)[l * 32 + n - 4] : 0.f); } }
    { bf16* GW = WSP(bf16, WS_GW);
      for (int i = gw * 64 + lane; i < 8 * 128 * 128 / 2; i += NGW * 64) { const int e = 2 * i, s = e & 127, t = (e >> 7) & 127; const float a = s <= t ? IN(7)[e] : 0.f, b = s + 1 <= t ? IN(7)[e + 1] : 0.f; ((unsigned*)GW)[i] = pk2(a, b); } }
    { float* RT = WSP(float, WS_ROPE);
      for (int i = gw * 64 + lane; i < 2048 * 8; i += NGW * 64) { const int pos = i >> 3, j = i & 7; const float inv = powf(500000.0f, -(float)j / 8.0f); const float ang = (float)pos * inv; RT[pos * 16 + j] = cosf(ang); RT[pos * 16 + 8 + j] = sinf(ang); } }
}
template <bool FLOG> __device__ __forceinline__ void p0_rows(Frame& F, const float* src, int layer) {
    const int lane = F.lane, r = lane & 15, q = lane >> 4, kh = F.wave >> 2, wp = F.wave & 3;
    LAS bf16* tH = (LAS bf16*)F.lds; LAS bf16* tL = tH + 8 * 1032; LAS float* rsl = (LAS float*)(F.lds + 40960) + F.wave * 16;
    LAS float* xch = (LAS float*)(F.lds + 49152) + wp * 512;
    __syncthreads();
    if (FLOG) {
        for (int idx = F.tid; idx < 8192; idx += NWAVES * 64) { const int n = idx & 7, k = idx >> 3; const float v = IN(3)[(size_t)k * EVEN_IN + 2560 + n] * IN(2)[k];
            const unsigned h = pk2(v, 0.f) & 0xffffu; tH[n * 1032 + k] = (bf16)h; tL[n * 1032 + k] = (bf16)(pk2(v - __builtin_bit_cast(float, h << 16), 0.f) & 0xffffu); }
        __syncthreads();
    }
    for (int task = F.vcu * 4 + wp; task < T / 16; task += F.G * 4) {
        const size_t row = (size_t)task * 16 + r;
        const float* xp = src + row * D + 512 * kh + 8 * q; bf16* hp = WSP(bf16, ws_hb(layer)) + row * D + 512 * kh + 8 * q;
        float ss = 0.f; f32x4 acc = {0.f, 0.f, 0.f, 0.f};
#pragma unroll 8
        for (int ks = 0; ks < 16; ++ks) {
            const f32x4 v0 = __builtin_nontemporal_load((const f32x4*)(xp + 32 * ks)), v1 = __builtin_nontemporal_load((const f32x4*)(xp + 32 * ks + 4));
            ss += (v0.x * v0.x + v0.y * v0.y) + (v0.z * v0.z + v0.w * v0.w) + (v1.x * v1.x + v1.y * v1.y) + (v1.z * v1.z + v1.w * v1.w);
            v4u o; o.x = pk2(v0.x, v0.y); o.y = pk2(v0.z, v0.w); o.z = pk2(v1.x, v1.y); o.w = pk2(v1.z, v1.w);
            wt16(ws_rsrc(F.ws), F.ws, hp + 32 * ks, o);
            if (FLOG) { bf16x8 bh = {0, 0, 0, 0, 0, 0, 0, 0}, bl = {0, 0, 0, 0, 0, 0, 0, 0};
                if (r < 8) { bh = *(const LAS bf16x8*)(tH + r * 1032 + 512 * kh + 32 * ks + 8 * q); bl = *(const LAS bf16x8*)(tL + r * 1032 + 512 * kh + 32 * ks + 8 * q); }
                const bf16x8 a = __builtin_bit_cast(bf16x8, o);
                acc = __builtin_amdgcn_mfma_f32_16x16x32_bf16(a, bh, acc, 0, 0, 0); acc = __builtin_amdgcn_mfma_f32_16x16x32_bf16(a, bl, acc, 0, 0, 0); }
        }
        *(f32x2*)(WSP(float, ws_ssq(layer)) + row * 16 + 4 * q + 2 * kh) = (f32x2){ss, 0.f};
        if (FLOG) {
            const float st = pg8::quad_sum(ss);
            if (kh == 1) { *(LAS f32x4*)(xch + lane * 8) = acc; xch[lane * 8 + 4] = st; }
            __syncthreads();
            if (kh == 0) {
                const f32x4 pa = *(const LAS f32x4*)(xch + lane * 8); const float ps = xch[lane * 8 + 4];
                acc = acc + pa;
                const float rs = rsqrtf((st + ps) * (1.f / D) + EPS);
                if (q == 0) rsl[r] = rs;
                LDS_WAIT(); asm volatile("" ::: "memory");
                const f32x4 r4 = *(const LAS f32x4*)(rsl + 4 * q);
                if (r < 8) { float* o = WSP(float, WS_CFL) + ((size_t)task * 16 + 4 * q) * 8 + r; o[0] = acc[0] * r4.x; o[8] = acc[1] * r4.y; o[16] = acc[2] * r4.z; o[24] = acc[3] * r4.w; }
            }
            __syncthreads();
        }
    }
}

struct GmlpIn { v4u w0, w1; f32x4 gs[4]; v2u uw[4]; };
__device__ __forceinline__ void gmlp_load(Frame& F, int chunk, int g, GmlpIn& in, int tid, int tb, int db, int r32, int hi) {
    const int s = tid >> 2, cg = (tid & 3) * 16; const size_t tok = (size_t)chunk * 128 + s;
    const float* gsp = WSP(float, WS_GST) + tok * 16;
#pragma unroll
    for (int j = 0; j < 4; ++j) in.gs[j] = *(const f32x4*)(gsp + 4 * j);
    in.w0 = *(const v4u*)(WSP(bf16, WS_VG) + tok * 512 + g * 64 + cg); in.w1 = *(const v4u*)(WSP(bf16, WS_VG) + tok * 512 + g * 64 + cg + 8);
    const bf16* yp = WSP(bf16, WS_Y) + ((size_t)chunk * 128 + tb * 32 + r32) * 1024 + g * 64 + db * 32 + 4 * hi;
#pragma unroll
    for (int q = 0; q < 4; ++q) in.uw[q] = *(const v2u*)(yp + 8 * q);
}
__device__ __forceinline__ void gmlp_block(Frame& F, int layer) {
    const int tid = F.tid, lane = F.lane, wid = F.wave;
    LAS bf16* vnT = (LAS bf16*)F.lds;
    const int g = F.vcu & 7, db = wid & 1, tb = wid >> 1, r32 = lane & 31, hi = lane >> 5;
    const int nit = (1024 - F.vcu + F.G - 1) / F.G;
    if (nit <= 0) return;
    const bf16* Wg = WSP(bf16, WS_GW) + ((size_t)g * 128 + tb * 32 + r32) * 128 + hi * 8;
    bf16x8 bw[8];
#pragma unroll
    for (int ks = 0; ks < 8; ++ks) if (ks < 2 * (tb + 1)) bw[ks] = *(const bf16x8*)(Wg + ks * 16);
    const float bs = IN(8)[layer * 1024 + g * 128 + tb * 32 + r32];
    const int s = tid >> 2, cg = (tid & 3) * 16;
    float lg[16], lb[16];
    { const float* lgp = IN(5) + layer * 512 + g * 64 + cg; const float* lbp = IN(6) + layer * 512 + g * 64 + cg;
#pragma unroll
      for (int j = 0; j < 4; ++j) { const f32x4 a = *(const f32x4*)(lgp + 4 * j), b = *(const f32x4*)(lbp + 4 * j); lg[4 * j] = a.x; lg[4 * j + 1] = a.y; lg[4 * j + 2] = a.z; lg[4 * j + 3] = a.w; lb[4 * j] = b.x; lb[4 * j + 1] = b.y; lb[4 * j + 2] = b.z; lb[4 * j + 3] = b.w; } }
    GmlpIn cur, nxt;
    gmlp_load(F, (F.vcu >> 3), g, cur, tid, tb, db, r32, hi);
#pragma unroll 1
    for (int j = 0; j < nit; ++j) {
        const int chunk = (F.vcu + F.G * j) >> 3;
        if (j + 1 < nit) gmlp_load(F, (F.vcu + F.G * (j + 1)) >> 3, g, nxt, tid, tb, db, r32, hi);
        { float sm = 0.f, sq = 0.f;
#pragma unroll
          for (int q = 0; q < 4; ++q) { sm += cur.gs[q].x + cur.gs[q].z; sq += cur.gs[q].y + cur.gs[q].w; }
          const float mu = sm * (1.f / 512.f), var = sq * (1.f / 512.f) - mu * mu, rs = rsqrtf(var + EPS);
          const unsigned ww[8] = {cur.w0.x, cur.w0.y, cur.w0.z, cur.w0.w, cur.w1.x, cur.w1.y, cur.w1.z, cur.w1.w};
#pragma unroll
          for (int q = 0; q < 8; ++q) { const float a = (bf_lo(ww[q]) - mu) * rs * lg[2 * q] + lb[2 * q], b = (bf_hi(ww[q]) - mu) * rs * lg[2 * q + 1] + lb[2 * q + 1];
              const unsigned pk = pk2(a, b); vnT[(cg + 2 * q) * 136 + s] = (bf16)(pk & 0xffffu); vnT[(cg + 2 * q + 1) * 136 + s] = (bf16)(pk >> 16); } }
        __syncthreads();
        f32x16 acc = {};
#pragma unroll
        for (int ks = 0; ks < 8; ++ks) if (ks < 2 * (tb + 1)) {
            const bf16x8 a = *(const LAS bf16x8*)(vnT + (db * 32 + r32) * 136 + ks * 16 + hi * 8);
            acc = __builtin_amdgcn_mfma_f32_32x32x16_bf16(a, bw[ks], acc, 0, 0, 0);
        }
        bf16* yp = WSP(bf16, WS_Y) + ((size_t)chunk * 128 + tb * 32 + r32) * 1024 + g * 64 + db * 32 + 4 * hi;
#pragma unroll
        for (int q = 0; q < 4; ++q) {
            v2u o; o.x = pk2(bf_lo(cur.uw[q].x) * (acc[4 * q] + bs), bf_hi(cur.uw[q].x) * (acc[4 * q + 1] + bs)); o.y = pk2(bf_lo(cur.uw[q].y) * (acc[4 * q + 2] + bs), bf_hi(cur.uw[q].y) * (acc[4 * q + 3] + bs));
            wt8(ws_rsrc(F.ws), F.ws, yp + 8 * q, o); }
        __syncthreads();
        cur = nxt;
    }
}

__device__ __forceinline__ void conv_load(Frame& F, int item, v4u (&hv)[8], int wid, int lane) {
    const int t0 = item * 32, pos0 = t0 & (SEQ - 1);
#pragma unroll
    for (int i = 0; i < 8; ++i) { const int r = wid + 8 * i; const int p = pos0 - 30 + r; hv[i] = (v4u){0u, 0u, 0u, 0u};
        if (r < 62 && p >= 0) hv[i] = *(const v4u*)(WSP(bf16, WS_VG) + (size_t)(t0 - 30 + r) * 512 + lane * 8); }
}
__device__ __forceinline__ void conv_block(Frame& F) {
    const int tid = F.tid, lane = F.lane, wid = F.wave;
    LAS bf16* hs = (LAS bf16*)F.lds;
    LAS float* cs = (LAS float*)(F.lds + 65536);
    const int nit = (512 - F.vcu + F.G - 1) / F.G;
    if (nit <= 0) return;
    float w[31];
#pragma unroll
    for (int k = 0; k < 31; ++k) w[k] = IN(16)[k * 512 + tid];
    const f32x4 g0 = *(const f32x4*)(IN(17) + lane * 8), g1 = *(const f32x4*)(IN(17) + lane * 8 + 4), b0 = *(const f32x4*)(IN(18) + lane * 8), b1 = *(const f32x4*)(IN(18) + lane * 8 + 4);
    v4u hv[8], hn[8];
    conv_load(F, F.vcu, hv, wid, lane);
#pragma unroll 1
    for (int j = 0; j < nit; ++j) {
        const int t0 = (F.vcu + F.G * j) * 32;
#pragma unroll
        for (int i = 0; i < 8; ++i) { const int r = wid + 8 * i; if (r < 62) *(LAS v4u*)(hs + r * 512 + lane * 8) = hv[i]; }
        if (j + 1 < nit) conv_load(F, F.vcu + F.G * (j + 1), hn, wid, lane);
        __syncthreads();
        float win[62];
#pragma unroll
        for (int r = 0; r < 62; ++r) win[r] = __builtin_bit_cast(float, (unsigned)hs[r * 512 + tid] << 16);
#pragma unroll
        for (int tt = 0; tt < 32; ++tt) { float a = 0.f;
#pragma unroll
            for (int k = 0; k < 31; ++k) a += w[k] * win[tt + k];
            cs[tt * 512 + tid] = a; }
        __syncthreads();
#pragma unroll
        for (int q = 0; q < 4; ++q) { const int tt = wid * 4 + q;
            const f32x4 a = *(const LAS f32x4*)(cs + tt * 512 + lane * 8), b = *(const LAS f32x4*)(cs + tt * 512 + lane * 8 + 4);
            const float mu = wave_sum((a.x + a.y) + (a.z + a.w) + (b.x + b.y) + (b.z + b.w)) * (1.f / 512.f);
            const f32x4 da = a - mu, db = b - mu;
            const float var = wave_sum((da.x * da.x + da.y * da.y) + (da.z * da.z + da.w * da.w) + (db.x * db.x + db.y * db.y) + (db.z * db.z + db.w * db.w)) * (1.f / 512.f);
            const float rs = rsqrtf(var + EPS);
            f32x4 y0 = da * rs * g0 + b0, y1 = db * rs * g1 + b1;
#pragma unroll
            for (int i = 0; i < 4; ++i) { y0[i] = pg8::fast_silu(y0[i]); y1[i] = pg8::fast_silu(y1[i]); }
            pg8::store8(ws_rsrc(F.ws), F.ws, WSP(bf16, WS_Y) + (size_t)(t0 + tt) * 1024 + 512 + lane * 8, y0, y1); }
        __syncthreads();
#pragma unroll
        for (int i = 0; i < 8; ++i) hv[i] = hn[i];
    }
}

__device__ __forceinline__ void router_phase(Frame& F, int layer) {
    const int lane = F.lane, wid = F.wave, tid = F.tid;
    LAS float* part = (LAS float*)F.lds;
    LAS float* lg = (LAS float*)(F.lds + 98304);
    const bf16* RH = WSP(bf16, WS_RW) + (size_t)layer * 48 * 1024; const bf16* RL = RH + 2 * 48 * 1024; const float* RB = WSP(float, WS_RB) + layer * 48;
    const int fr = lane & 15, fq = lane >> 4;
    for (int blk = F.vcu; blk < T / 64; blk += F.G) {
        bf16x8 a[4][4], bh[3][4], bl[3][4];
#pragma unroll
        for (int t = 0; t < 4; ++t)
#pragma unroll
            for (int ks = 0; ks < 4; ++ks) a[t][ks] = *(const bf16x8*)(WSP(bf16, ws_hb(layer)) + (size_t)(blk * 64 + t * 16 + fr) * D + 128 * wid + 32 * ks + 8 * fq);
#pragma unroll
        for (int f = 0; f < 3; ++f)
#pragma unroll
            for (int ks = 0; ks < 4; ++ks) { const size_t o = (size_t)(fr + 16 * f) * 1024 + 128 * wid + 32 * ks + 8 * fq; bh[f][ks] = *(const bf16x8*)(RH + o); bl[f][ks] = *(const bf16x8*)(RL + o); }
#pragma unroll
        for (int t = 0; t < 4; ++t) {
            f32x4 acc[3] = {{0.f, 0.f, 0.f, 0.f}, {0.f, 0.f, 0.f, 0.f}, {0.f, 0.f, 0.f, 0.f}};
#pragma unroll
            for (int ks = 0; ks < 4; ++ks)
#pragma unroll
                for (int f = 0; f < 3; ++f) { acc[f] = __builtin_amdgcn_mfma_f32_16x16x32_bf16(a[t][ks], bh[f][ks], acc[f], 0, 0, 0); acc[f] = __builtin_amdgcn_mfma_f32_16x16x32_bf16(a[t][ks], bl[f][ks], acc[f], 0, 0, 0); }
#pragma unroll
            for (int f = 0; f < 3; ++f)
#pragma unroll
                for (int r = 0; r < 4; ++r) part[wid * 3072 + (t * 16 + 4 * fq + r) * 48 + 16 * f + fr] = acc[f][r];
        }
        __syncthreads();
        for (int i = tid; i < 3072; i += NWAVES * 64) { float s = 0.f;
#pragma unroll
            for (int w = 0; w < 8; ++w) s += part[w * 3072 + i];
            lg[i] = s; }
        __syncthreads();
        if (wid == 0) {
            const int tok = blk * 64 + lane;
            const float* sp = WSP(float, ws_ssq(layer)) + (size_t)tok * 16; float ss = 0.f;
#pragma unroll
            for (int j = 0; j < 4; ++j) { const f32x4 p = *(const f32x4*)(sp + 4 * j); ss += (p.x + p.y) + (p.z + p.w); }
            const float rs = rsqrtf(ss * (1.f / D) + EPS);
            float pc[4];
#pragma unroll
            for (int j = 0; j < 4; ++j) pc[j] = lg[lane * 48 + j] * rs + RB[j];
            int g = 0; float cm = pc[0];
#pragma unroll
            for (int j = 1; j < 4; ++j) if (pc[j] > cm) { cm = pc[j]; g = j; }
            float den = 0.f;
#pragma unroll
            for (int j = 0; j < 4; ++j) den += __expf(pc[j] - cm);
            const float pg = 1.f / den;
            float fv[8];
#pragma unroll
            for (int j = 0; j < 8; ++j) fv[j] = lg[lane * 48 + 4 + g * 8 + j] * rs + RB[4 + g * 8 + j];
            int i0 = 0; float v0 = fv[0];
#pragma unroll
            for (int j = 1; j < 8; ++j) if (fv[j] > v0) { v0 = fv[j]; i0 = j; }
            int i1 = -1; float v1 = -INFINITY;
#pragma unroll
            for (int j = 0; j < 8; ++j) if (j != i0 && (i1 < 0 || fv[j] > v1)) { v1 = fv[j]; i1 = j; }
            const float e1 = __expf(v1 - v0);
            const float p0 = pg / (1.f + e1), p1 = pg * e1 / (1.f + e1);
            const int e0 = g * 8 + i0, e1i = g * 8 + i1;
            int r0 = 0, r1 = 0, mycnt = 0;
            const unsigned long long lt = (1ull << lane) - 1ull;
#pragma unroll 1
            for (int e = 0; e < NE; ++e) {
                const unsigned long long m0 = __ballot(e0 == e), m1 = __ballot(e1i == e);
                const int below = __popcll(m0 & lt) + __popcll(m1 & lt);
                if (e0 == e) r0 = below; if (e1i == e) r1 = below;
                if (lane == e) mycnt = __popcll(m0) + __popcll(m1);
            }
            int* eid = WSP(int, WS_EID); float* ew = WSP(float, WS_EW); int* lr = WSP(int, WS_LRANK);
            eid[tok * 2] = e0; eid[tok * 2 + 1] = e1i; ew[tok * 2] = p0; ew[tok * 2 + 1] = p1; lr[tok * 2] = r0; lr[tok * 2 + 1] = r1;
            if (lane < NE) WSP(int, WS_BCNT)[blk * NE + lane] = mycnt;
        }
        __syncthreads();
    }
}

__device__ __forceinline__ void moe_segments(Frame& F, LAS int* seg, LAS int* scr, int myblk) {
    const int tid = F.tid, e = tid & 31, part = tid >> 5;
    const int* bc = WSP(int, WS_BCNT);
    int s = 0, sb = 0;
#pragma unroll 4
    for (int i = 0; i < 16; ++i) { const int b = part * 16 + i; const int c = bc[b * NE + e]; s += c; if (b < myblk) sb += c; }
    scr[part * 32 + e] = s; scr[512 + part * 32 + e] = sb;
    __syncthreads();
    if (tid < 32) { int tot = 0, base = 0;
#pragma unroll
        for (int p = 0; p < 16; ++p) { tot += scr[p * 32 + tid]; base += scr[512 + p * 32 + tid]; }
        seg[64 + tid] = base; seg[128 + tid] = tot; scr[tid] = (tot + 255) & ~255; }
    __syncthreads();
    if (tid == 0) { int off = 0; for (int k = 0; k < NE; ++k) { seg[k] = off; off += scr[k]; } seg[NE] = off; }
    __syncthreads();
    if (tid < ROWS_MAX / 256) { int e = 0;
#pragma unroll 1
        for (int k = 1; k < NE; ++k) if ((seg[k] >> 8) <= tid) e = k;
        seg[192 + tid] = e; }
    __syncthreads();
}
__device__ __forceinline__ void dispatch_phase(Frame& F, int layer) {
    LAS int* seg = (LAS int*)(F.lds + MISC_OFF + 1024); LAS int* scr = (LAS int*)F.lds;
    const int lane = F.lane, wid = F.wave;
    const int* eid = WSP(int, WS_EID); const float* ew = WSP(float, WS_EW); const int* lr = WSP(int, WS_LRANK); int* tokpos = WSP(int, WS_TOKPOS); float* roww = WSP(float, WS_ROWW); float* rowrs = WSP(float, WS_ROWRS);
    for (int blk = F.vcu; blk < T / 64; blk += F.G) {
        moe_segments(F, seg, scr, blk);
        if (blk < NE) { const int b = seg[blk] + seg[128 + blk], en = seg[blk + 1];
            for (int r = b + F.tid; r < en; r += NWAVES * 64) { roww[r] = 0.f; rowrs[r] = 0.f; WSP(int, WS_ROWTOK)[r] = 0; } }
        const int base = blk * 64 + wid * 8;
        int pos = 0;
        if (lane < 16) { const int tok = base + (lane >> 1), j = lane & 1; const int e = eid[tok * 2 + j];
            pos = seg[e] + seg[64 + e] + lr[tok * 2 + j];
            const float* sp = WSP(float, ws_ssq(layer)) + (size_t)tok * 16; float ss = 0.f;
#pragma unroll
            for (int q = 0; q < 4; ++q) { const f32x4 p = *(const f32x4*)(sp + 4 * q); ss += (p.x + p.y) + (p.z + p.w); }
            roww[pos] = ew[tok * 2 + j]; rowrs[pos] = rsqrtf(ss * (1.f / D) + EPS); tokpos[tok * 2 + j] = pos; WSP(int, WS_ROWTOK)[pos] = tok; }
        __syncthreads();
    }
}
template <int NT, int BPE> struct GroupedOrder {
    const LAS int* seg; int G, c;
    __device__ __forceinline__ bool next(int i, pg8::Unit& u) const {
        const int L = i * G + c; const int total = (seg[NE] >> 8) * NT; if (L >= total) return false;
        const int mt = L / NT, nt = L % NT; const int e = seg[192 + mt];
        u.pm = mt; u.pn = e * BPE + nt; u.pc = nt; return true;
    }
    __device__ __forceinline__ void a_ready(const pg8::Unit&) const {}
    __device__ __forceinline__ void done(const pg8::Unit&) const {}
};
__device__ __forceinline__ void combine_phase(Frame& F, int layer) {
    const int lane = F.lane, gw = F.vcu * NWAVES + F.wave, NGW = F.G * NWAVES;
    const int* tokpos = WSP(int, WS_TOKPOS);
    for (int m = gw; m < T; m += NGW) {
        const int p0 = tokpos[m * 2], p1 = tokpos[m * 2 + 1];
        GAS v4u* hr = (GAS v4u*)(WSP(bf16, ws_hb(layer)) + (size_t)m * D) + 2 * lane;
        const GAS v4u* a = (const GAS v4u*)(WSP(bf16, WS_MG) + (size_t)p0 * D) + 2 * lane; const GAS v4u* b = (const GAS v4u*)(WSP(bf16, WS_MG) + (size_t)p1 * D) + 2 * lane;
        const v4u h0 = hr[0], h1 = hr[1], a0 = __builtin_nontemporal_load(a), a1 = __builtin_nontemporal_load(a + 1), b0 = __builtin_nontemporal_load(b), b1 = __builtin_nontemporal_load(b + 1);
        const unsigned hw[8] = {h0.x, h0.y, h0.z, h0.w, h1.x, h1.y, h1.z, h1.w}, aw[8] = {a0.x, a0.y, a0.z, a0.w, a1.x, a1.y, a1.z, a1.w}, bw[8] = {b0.x, b0.y, b0.z, b0.w, b1.x, b1.y, b1.z, b1.w};
        unsigned ow[8]; float s = 0.f;
#pragma unroll
        for (int j = 0; j < 8; ++j) { const float lo = bf_lo(hw[j]) + bf_lo(aw[j]) + bf_lo(bw[j]), hi = bf_hi(hw[j]) + bf_hi(aw[j]) + bf_hi(bw[j]); ow[j] = pk2(lo, hi); s += lo * lo + hi * hi; }
        wt16(ws_rsrc(F.ws), F.ws, (const void*)hr, (v4u){ow[0], ow[1], ow[2], ow[3]}); wt16(ws_rsrc(F.ws), F.ws, (const void*)(hr + 1), (v4u){ow[4], ow[5], ow[6], ow[7]});
        s += xor_lane<1>(s); s += xor_lane<2>(s);
        if ((lane & 3) == 0) WSP(float, ws_ssq(layer))[(size_t)m * 16 + (lane >> 2)] = s;
    }
}

#ifndef MK_SP2K
#define MK_SP2K true
#endif
constexpr int N_PHASES = 19;
__global__ void __launch_bounds__(NWAVES * 64, 2) mega(Args args) {
    extern __shared__ __attribute__((aligned(16))) unsigned char lds[];
    Frame F;
    F.lds = (LAS unsigned char*)lds; F.ws = args.ws; F.ctl = (gu32*)(args.ws + WS_CTL); F.out = (args.flags & 32) ? (float*)(args.ws + WS_HB) : args.out;
    F.tid = threadIdx.x; F.lane = F.tid & 63; F.wave = __builtin_amdgcn_readfirstlane(F.tid >> 6);
    F.G = gridDim.x; { const int bx = blockIdx.x; F.vcu = (F.G % 8 == 0) ? (bx % 8) * (F.G / 8) + bx / 8 : bx; }
    volatile LAS unsigned* MISC = (volatile LAS unsigned*)(F.lds + MISC_OFF);
    for (int u = F.tid; u < 64; u += NWAVES * 64) MISC[u] = 0u;
    __syncthreads();
    XcdBarrier bar = xcd_barrier_post((unsigned*)(F.ctl + CW_BAR) + args.li * XCD_BAR_WORDS, MISC + 8);
    const int lo = args.ph_lo, hi = args.ph_hi;
#ifndef MK_QX
#define MK_QX 1
#endif
    int idle_i = -1, idle_n = 0;
#ifndef MK_ONLY
#define MK_ONLY -1
#endif
#define PH(k) ((MK_ONLY < 0 || MK_ONLY == ((k) == 0 ? 0 : 1 + ((k) - 1) % 9)) && lo <= (k) && (k) < hi)
#define SEAM(k) do { if (PH(k) && PH((k) + 1)) { __syncthreads(); if (!(args.flags & 64)) q_seam(F, (k), idle_i, idle_n); xcd_barrier(bar); } idle_i = -1; idle_n = 0; OPAQ(); } while (0)
#define OPAQ() do { asm volatile("" : "+s"(F.wave), "+s"(F.vcu)); F.lane = lane_id(); asm volatile("" : "+v"(F.lane)); F.tid = F.wave * 64 + F.lane; } while (0)
    if (PH(0)) {
        if (args.flags & 1) p0_weights(F);
        if (args.flags & 2) p0_rows<true>(F, args.prep_src, args.prep_layer);
        if (args.flags & 4) p0_rows<false>(F, args.prep_src, args.prep_layer);
    }
    SEAM(0);
#pragma unroll 1
    for (int layer = 0; layer < 2; ++layer) {
        const int pb = 1 + 9 * layer;
        if (PH(pb + 0)) {
#ifndef MK_K0
#define MK_K0 7
#endif
            if (args.flags & 8) {} else if (layer == 0 && (MK_K0 & 1)) {
                pg8::Gemm g{WSP(bf16, ws_hb(0)), WSP(bf16, WS_WIN0), T, N_IN0, D}; pg8::StaticOrder S; S.init(T, N_IN0, F.G, (int)blockIdx.x);
                pg8::EpIn0 E{F.ws};
                pg8::gemm_phase<pg8::EpIn0, pg8::StaticOrder, true, true>(F.lds, g, S, E, F.wave);
                idle_n = 128; idle_i = (int)blockIdx.x - 128;
            } else if (MK_K0 & 2) {
                pg8::Gemm g{WSP(bf16, ws_hb(1)), WSP(bf16, WS_WIN1), T, N_IN1, D}; pg8::StaticOrder S; S.init(T, N_IN1, F.G, (int)blockIdx.x);
                pg8::EpIn1 E{F.ws};
                pg8::gemm_phase<pg8::EpIn1, pg8::StaticOrder, true, true>(F.lds, g, S, E, F.wave);
                idle_n = 64; idle_i = (int)blockIdx.x - 192;
            }
        }
        SEAM(pb + 0);
        if (PH(pb + 1)) {
            if (layer == 0) {
                const int bh = F.vcu >> 2, s = F.vcu & 3, b = bh >> 3, h = bh & 7;
#ifndef MK_MIX
#define MK_MIX 15
#endif
                if (bh < 64 && (MK_MIX & 1) && !(args.flags & 256)) {
                    attn_body::fox_scan(b, h, WSP(float, WS_CFL), IN(4)[h], (char*)lds, F.wave);
                    const attn_body::bf16* Yq = (const attn_body::bf16*)(WSP(bf16, WS_Y) + 512);
                    attn_body::fox_unit<8, 1024, 512>(b, h, s, Yq, (const attn_body::bf16*)WSP(bf16, WS_KB), (const attn_body::bf16*)WSP(bf16, WS_VB), (attn_body::bf16*)(WSP(bf16, WS_Y) + 512), (char*)lds, F.wave, F.ws);
                    attn_body::fox_unit<8, 1024, 512>(b, h, 7 - s, Yq, (const attn_body::bf16*)WSP(bf16, WS_KB), (const attn_body::bf16*)WSP(bf16, WS_VB), (attn_body::bf16*)(WSP(bf16, WS_Y) + 512), (char*)lds, F.wave, F.ws);
                }
                __syncthreads();
                if ((MK_MIX & 2) && !(args.flags & 512)) gmlp_block(F, 0);
            } else {
                if ((MK_MIX & 4) && !(args.flags & 256)) for (int it = F.vcu; it < 512; it += F.G) {
                    const int qb = it & 31, kvh = (it >> 5) & 1, b = it >> 6;
                    attn_body::swa_unit<1024, 128>(b, kvh, qb, (const attn_body::bf16*)WSP(bf16, WS_Y), (const attn_body::bf16*)WSP(bf16, WS_KB), (const attn_body::bf16*)WSP(bf16, WS_VB), (attn_body::bf16*)WSP(bf16, WS_Y), IN(15), (char*)lds, F.wave, F.ws);
                }
                __syncthreads();
                if ((MK_MIX & 8) && !(args.flags & 512)) conv_block(F);
            }
        }
        SEAM(pb + 1);
        if (PH(pb + 2)) {
            pg8::Gemm g{WSP(bf16, WS_Y), WSP(bf16, layer ? WS_WOUT1 : WS_WOUT0), T, D, D}; pg8::StaticOrder S; S.init(T, D, F.G, (int)blockIdx.x);
            pg8::EpRes<false> E{F.out, F.ws, layer};
            pg8::gemm_phase<pg8::EpRes<false>, pg8::StaticOrder, true, true>(F.lds, g, S, E, F.wave);
        }
        SEAM(pb + 2);
        if (PH(pb + 3)) router_phase(F, layer);
        SEAM(pb + 3);
        if (PH(pb + 4)) {
            if (!(args.flags & 16)) dispatch_phase(F, layer);
        }
        SEAM(pb + 4);
        if (PH(pb + 5)) {
            LAS int* seg = (LAS int*)(F.lds + MISC_OFF + 1024); moe_segments(F, seg, (LAS int*)F.lds, 0);
            pg8::Gemm g{WSP(bf16, ws_hb(layer)), WSP(bf16, WS_W1) + (size_t)layer * NE * 512 * 1024, ROWS_MAX, 512, D};
            GroupedOrder<2, 2> S{seg, F.G, F.vcu};
            pg8::EpMoe1 E{F.ws};
            pg8::gemm_phase<pg8::EpMoe1, GroupedOrder<2, 2>, true, true, true>(F.lds, g, S, E, F.wave, WSP(int, WS_ROWTOK));
            { const int tot = (seg[NE] >> 8) * 2, rounds = (tot + F.G - 1) / F.G, first = tot - (rounds - 1) * F.G; idle_n = F.G - first; idle_i = F.vcu - first; }
            if (idle_n <= 0 || idle_i >= 0) { pg8::Gemm g{WSP(bf16, WS_PB) + (size_t)layer * T * DPLE, WSP(bf16, WS_WPP) + (size_t)layer * 1024 * 256, T, D, DPLE}; pg8::StaticOrder S; S.init(T, D, idle_n > 0 ? idle_n : F.G, idle_n > 0 ? idle_i : F.vcu);
              pg8::EpBf16 E{WSP(bf16, WS_PP), 1024, F.ws};
              pg8::gemm_phase<pg8::EpBf16, pg8::StaticOrder, true, MK_SP2K>(F.lds, g, S, E, F.wave); }

        }
        SEAM(pb + 5);
        if (PH(pb + 6)) {
            LAS int* seg = (LAS int*)(F.lds + MISC_OFF + 1024); moe_segments(F, seg, (LAS int*)F.lds, 0);
            pg8::Gemm g{WSP(bf16, WS_HID), WSP(bf16, WS_W2) + (size_t)layer * NE * 1024 * 256, ROWS_MAX, 1024, DEXP};
            GroupedOrder<4, 4> S{seg, F.G, F.vcu};
            pg8::EpBf16 E{WSP(bf16, WS_MG), (args.flags & 1024) ? -1 : 1024, F.ws};
            pg8::gemm_phase<pg8::EpBf16, GroupedOrder<4, 4>, true, MK_SP2K>(F.lds, g, S, E, F.wave);
            { const int tot = (seg[NE] >> 8) * 4, rounds = (tot + F.G - 1) / F.G, first = tot - (rounds - 1) * F.G; idle_n = F.G - first; idle_i = F.vcu - first; }
        }
        SEAM(pb + 6);
        if (PH(pb + 7)) combine_phase(F, layer);
        SEAM(pb + 7);
        if (PH(pb + 8)) {
            pg8::Gemm g{WSP(bf16, ws_hb(layer)), WSP(bf16, WS_WPG) + (size_t)layer * 1024 * 1024, T, D, D}; pg8::StaticOrder S; S.init(T, D, F.G, (int)blockIdx.x);
            pg8::EpRes<true> E{F.out, F.ws, layer};
            pg8::gemm_phase<pg8::EpRes<true>, pg8::StaticOrder, true, true>(F.lds, g, S, E, F.wave);
        }
        SEAM(pb + 8);
    }
#undef PH
#undef SEAM
}
}

#ifndef MK_CFG
#define MK_CFG 0
#endif
static void naive_mix(int layer, void* const* d_in, float* h, char* ws, hipStream_t stream);
static void naive_moe(int layer, void* const* d_in, float* h, char* ws, hipStream_t stream);
static void naive_ple(int layer, void* const* d_in, float* h, char* ws, hipStream_t stream);

extern "C" void kernel_launch(void* const* d_in, const int* in_sizes, int n_in, void* d_out, int out_size, void* d_ws, size_t ws_size, hipStream_t stream) {
    using namespace mk;
    static int grid = 0;
    if (grid == 0) {
        if (n_in != 31 || out_size != T * D || ws_size < WS_END) { fprintf(stderr, "kernel_launch: unexpected shapes (n_in %d out %d ws %zu, need %zu)\n", n_in, out_size, ws_size, (size_t)WS_END); grid = -1; return; }
        int dev = 0, cus = 0, per_cu = 0;
        if (hipGetDevice(&dev) != hipSuccess || hipDeviceGetAttribute(&cus, hipDeviceAttributeMultiprocessorCount, dev) != hipSuccess) { grid = -1; return; }
        if (hipFuncSetAttribute((const void*)mega, hipFuncAttributeMaxDynamicSharedMemorySize, LDS_BYTES) != hipSuccess) { fprintf(stderr, "kernel_launch: hipFuncSetAttribute failed\n"); grid = -1; return; }
        if (hipOccupancyMaxActiveBlocksPerMultiprocessor(&per_cu, (const void*)mega, NWAVES * 64, LDS_BYTES) != hipSuccess || per_cu < 1) { fprintf(stderr, "kernel_launch: occupancy query says %d\n", per_cu); per_cu = 1; }
        (void)hipGetLastError();
        grid = cus;
        if (grid != 256) { fprintf(stderr, "kernel_launch: built for 256 CUs, got %d\n", grid); grid = -1; return; }
    }
    if (grid < 0) return;
    (void)hipMemsetAsync((char*)d_ws + WS_CTL, 0, CTL_ZERO_BYTES, stream);
    Args a{};
    for (int i = 0; i < 31; ++i) a.in[i] = (const float*)d_in[i];
    a.out = (float*)d_out; a.ws = (unsigned char*)d_ws;
    int li = 0;
    auto launch = [&](int lo, int hi, int flags, const float* prep_src, int prep_layer) {
        a.ph_lo = lo; a.ph_hi = hi; a.flags = flags; a.prep_src = prep_src; a.prep_layer = prep_layer; a.li = li++;
        hipLaunchKernelGGL(mega, dim3(grid), dim3(NWAVES * 64), LDS_BYTES, stream, a);
    };
#if MK_CFG == 0
    launch(0, N_PHASES, 1 | 2, (const float*)d_in[0], 0);
#elif MK_CFG == 2
    launch(0, N_PHASES, 1 | 2, (const float*)d_in[0], 0);
    for (int r = 0; r < MK_REP; ++r) { (void)hipMemsetAsync((char*)d_ws + WS_CTL, 0, 16384, stream); launch(MK_PLO, MK_PHI, 32 | 64 | (MK_PLO == 0 ? MK_PFLAGS : (MK_PFLAGS & ~3)), (const float*)d_in[0], 0); }
#elif MK_CFG == 1
    launch(0, 1, 1 | 2, (const float*)d_in[0], 0);
    for (int p = 1; p < N_PHASES; ++p) launch(p, p + 1, 0, nullptr, 0);
#else
    {
        const int bits = MK_CFG - 100; float* h = (float*)d_out; char* ws = (char*)d_ws;
        (void)hipMemcpyAsync(h, d_in[0], (size_t)T * D * 4, hipMemcpyDeviceToDevice, stream);
        for (int layer = 0; layer < 2; ++layer) {
            const int pb = 1 + 9 * layer;
            if (bits & (1 << (3 * layer + 0))) { launch(0, 1, 1, nullptr, 0); launch(0, 1, layer == 0 ? 2 : 4, h, layer); for (int p = pb; p < pb + 3; ++p) launch(p, p + 1, 0, nullptr, 0); }
            else naive_mix(layer, d_in, h, ws, stream);
            if (bits & (1 << (3 * layer + 1))) { (void)hipMemsetAsync((char*)d_ws + WS_CTL, 0, 4096, stream); launch(0, 1, 1, nullptr, 0); launch(0, 1, 4, h, layer); for (int p = pb + 3; p < pb + 8; ++p) launch(p, p + 1, 0, nullptr, 0); }
            else naive_moe(layer, d_in, h, ws, stream);
            if (bits & (1 << (3 * layer + 2))) { launch(0, 1, 1, nullptr, 0); launch(0, 1, 4, h, layer); launch(pb + 4, pb + 5, 16, nullptr, 0); launch(pb + 8, pb + 9, 0, nullptr, 0); }
            else naive_ple(layer, d_in, h, ws, stream);
        }
    }
#endif
}
```

```cpp
#define MK_CFG 0
#define MK_PLO 0
#define MK_PHI 0
#define MK_REP 1
#define MK_PFLAGS 3
#include <hip/hip_runtime.h>
#include <cstdio>
#include <cstdint>
namespace mk {
constexpr int NWAVES = 8;
constexpr int T = 16384, D = 1024, SEQ = 2048, NB = 8, NE = 32, DEXP = 256, DPLE = 256;
constexpr int EVEN_IN = 2568, ODD_IN = 1792, N_IN0 = 2560, N_IN1 = 1792;
constexpr int ROWS_MAX = T * 2 + NE * 256;
constexpr float EPS = 1e-6f;
constexpr size_t MiB = 1u << 20;
constexpr size_t WS_CTL = 0, CTL_ZERO_BYTES = 1 * MiB;
constexpr size_t WS_SSQ = 1 * MiB;
constexpr size_t WS_GST = 2 * MiB;
constexpr size_t WS_EID = 3 * MiB, WS_EW = WS_EID + 128 * 1024, WS_TOKPOS = WS_EW + 128 * 1024, WS_ROWW = WS_TOKPOS + 128 * 1024, WS_ROWRS = WS_ROWW + 160 * 1024, WS_LRANK = WS_ROWRS + 160 * 1024, WS_BCNT = WS_LRANK + 128 * 1024, WS_ROWTOK = WS_BCNT + 32 * 1024;
constexpr size_t WS_RW = 4 * MiB;
constexpr size_t WS_RB = WS_RW + 2 * 48 * 1024 * 4;
constexpr size_t WS_GW = WS_RB + 4096;
constexpr size_t WS_ROPE = WS_GW + 8 * 128 * 128 * 2;
constexpr size_t WS_CFL = 5 * MiB;
constexpr size_t WS_WIN0 = 6 * MiB, WS_WOUT0 = 11 * MiB, WS_WIN1 = 13 * MiB, WS_WOUT1 = 17 * MiB, WS_WPG = 19 * MiB, WS_WPP = 23 * MiB, WS_W1 = 24 * MiB, WS_W2 = 88 * MiB;
constexpr size_t WS_HB = 120 * MiB;
constexpr size_t WS_PB = 152 * MiB;
constexpr size_t WS_PP = 168 * MiB;
constexpr size_t WS_Y = 200 * MiB, WS_VG = 232 * MiB, WS_KB = 248 * MiB, WS_VB = 264 * MiB;
constexpr size_t WS_MG = 200 * MiB;
constexpr size_t WS_HID = 280 * MiB;
constexpr size_t WS_SSQ2 = 300 * MiB;
constexpr size_t WS_END = 301 * MiB;
__host__ __device__ constexpr size_t ws_hb(int layer) { return layer ? WS_W1 : WS_HB; }
__host__ __device__ constexpr size_t ws_ssq(int layer) { return layer ? WS_SSQ2 : WS_SSQ; }
constexpr int CW_TMO = 0;
constexpr int CW_CNT = 64, CW_CUR = 128;
constexpr int CW_QHEAD = 192, CW_ARRIVE = 1024;
constexpr int CW_BAR = 4096;
constexpr int RING_BYTES = 131072, MISC_OFF = RING_BYTES, LDS_BYTES = 147456;

__device__ __forceinline__ const float* in_ptr(int i) {
    const __attribute__((address_space(4))) char* ka = (const __attribute__((address_space(4))) char*)__builtin_amdgcn_kernarg_segment_ptr();
    asm volatile("" : "+s"(ka));
    return *(const float* const __attribute__((address_space(4)))*)(ka + 8 * i);
}
typedef unsigned wt_u32x4 __attribute__((ext_vector_type(4)));
typedef unsigned wt_u32x2 __attribute__((ext_vector_type(2)));
__device__ __forceinline__ __amdgpu_buffer_rsrc_t ws_rsrc(const void* ws) { return __builtin_amdgcn_make_buffer_rsrc((void*)ws, 0, 0x7ffffff0, 0x00020000); }
#ifndef MK_WT
#define MK_WT 0
#endif
__device__ __forceinline__ void wt16(__amdgpu_buffer_rsrc_t r, const void* ws, const void* p, wt_u32x4 v) { if (MK_WT & 1) __builtin_amdgcn_raw_buffer_store_b128(v, r, (int)((const unsigned char*)p - (const unsigned char*)ws), 0, 16); else *(wt_u32x4*)p = v; }
__device__ __forceinline__ void wt16c(__amdgpu_buffer_rsrc_t r, const void* ws, const void* p, wt_u32x4 v) { if (MK_WT & 2) __builtin_amdgcn_raw_buffer_store_b128(v, r, (int)((const unsigned char*)p - (const unsigned char*)ws), 0, 16); else *(wt_u32x4*)p = v; }
__device__ __forceinline__ void wt8(__amdgpu_buffer_rsrc_t r, const void* ws, const void* p, wt_u32x2 v) { if (MK_WT & 1) __builtin_amdgcn_raw_buffer_store_b64(v, r, (int)((const unsigned char*)p - (const unsigned char*)ws), 0, 16); else *(wt_u32x2*)p = v; }
__device__ __forceinline__ int lane_id() { return (int)__builtin_amdgcn_mbcnt_hi(~0u, __builtin_amdgcn_mbcnt_lo(~0u, 0u)); }
template <int M> __device__ __forceinline__ float xor_lane(float v) {
    if constexpr (M == 32) { auto rr = __builtin_amdgcn_permlane32_swap(__float_as_uint(v), __float_as_uint(v), false, false); return __uint_as_float(rr[0]) == v ? __uint_as_float(rr[1]) : __uint_as_float(rr[0]); }
    else return __builtin_bit_cast(float, __builtin_amdgcn_ds_swizzle(__builtin_bit_cast(int, v), (M << 10) | 0x1f));
}
__device__ __forceinline__ float sum_xor32(float v) { auto rr = __builtin_amdgcn_permlane32_swap(__float_as_uint(v), __float_as_uint(v), false, false); return __uint_as_float(rr[0]) + __uint_as_float(rr[1]); }
template <int CTRL> __device__ __forceinline__ float dpp_f(float v) { return __builtin_bit_cast(float, __builtin_amdgcn_update_dpp(0, __builtin_bit_cast(int, v), CTRL, 0xf, 0xf, true)); }
__device__ __forceinline__ float wave_sum64(float v) { v += dpp_f<0xB1>(v); v += dpp_f<0x4E>(v); v += dpp_f<0x141>(v); v += dpp_f<0x140>(v); v += xor_lane<16>(v); return sum_xor32(v); }
}
namespace pg8 {
#define PG8_LAS __attribute__((address_space(3)))
typedef unsigned short bf16_t;
typedef short bf16x8 __attribute__((ext_vector_type(8)));
typedef float f32x4 __attribute__((ext_vector_type(4)));
typedef unsigned u32x4 __attribute__((ext_vector_type(4)));
constexpr int BM = 256, BK = 64, HALF = 128, HTB = HALF * BK * 2  , STAGE_BYTES = 8 * HTB, NXCD = 8, WGM = 8;

__host__ __device__ __forceinline__ int lds_byte(int r, int c) { const int st = (r >> 4) * 2 + (c >> 5), rr = r & 15, cc = c & 31, ob = rr * 64 + cc * 2; return st * 1024 + (ob ^ (((ob >> 9) & 1) << 5)); }
__host__ __device__ __forceinline__ void stage_rc(int b, int& R, int& C) { const int st = b / 1024, sb = b % 1024, swz = sb ^ (((sb >> 9) & 1) << 5); R = (st >> 1) * 16 + swz / 64; C = (st & 1) * 32 + (swz % 64) / 2; }
__host__ __device__ __forceinline__ int perm32(int rho) { const int n = rho >> 4, i = rho & 15; return 8 * (i >> 2) + 4 * n + (i & 3); }

struct Unit { int pm, pn, pc; };
struct Gemm { const bf16_t* A; const bf16_t* Bt; int M, N, K; };

struct StaticOrder {
    int nM, nN, nwg, G, c;
    __host__ __device__ void init(int M, int N, int G_, int c_) { nM = M / BM; nN = N / BM; nwg = nM * nN; G = G_; c = c_; }
    __host__ __device__ bool next(int i, Unit& u) const {
        const long L = (long)i * G + c; if (L >= nwg) return false;
        int wgid = (int)L; { const int q = nwg / NXCD, r = nwg % NXCD, xcd = wgid % NXCD, off = wgid / NXCD; wgid = (xcd < r ? xcd * (q + 1) : r * (q + 1) + (xcd - r) * q) + off; }
        const int nig = WGM * nN, gid = wgid / nig, fm = gid * WGM, gsz = (nM - fm) < WGM ? (nM - fm) : WGM;
        u.pm = fm + ((wgid % nig) % gsz); u.pn = (wgid % nig) / gsz; u.pc = u.pn; return true;
    }
    __device__ __forceinline__ void a_ready(const Unit&) const {}
    __device__ __forceinline__ void done(const Unit&) const {}
};

typedef float f32x2 __attribute__((ext_vector_type(2)));
typedef __bf16 bf16x2_t __attribute__((ext_vector_type(2)));
constexpr float EPS = 1e-6f, LOG2E = 1.4426950408889634f, C2 = 0.125f * 1.4426950408889634f;
__device__ __forceinline__ unsigned cvt_pk_bf16(float lo, float hi) { f32x2 v = {lo, hi}; bf16x2_t b = __builtin_convertvector(v, bf16x2_t); return __builtin_bit_cast(unsigned, b); }
__device__ __forceinline__ float bf_lo(unsigned w) { return __builtin_bit_cast(float, w << 16); }
__device__ __forceinline__ float bf_hi(unsigned w) { return __builtin_bit_cast(float, w & 0xffff0000u); }
__device__ __forceinline__ float fast_sigmoid(float x) { return __builtin_amdgcn_rcpf(1.f + __builtin_amdgcn_exp2f(-LOG2E * x)); }
__device__ __forceinline__ float fast_silu(float x) { return x * fast_sigmoid(x); }
__device__ __forceinline__ float fast_gelu_tanh(float x) { const float t = x + 0.044715f * x * x * x; return x * __builtin_amdgcn_rcpf(1.f + __builtin_amdgcn_exp2f(-2.302208198f * t)); }
__device__ __forceinline__ void store8(__amdgpu_buffer_rsrc_t R, const void* ws, bf16_t* p, const f32x4 v0, const f32x4 v1) { u32x4 w; w.x = cvt_pk_bf16(v0[0], v0[1]); w.y = cvt_pk_bf16(v0[2], v0[3]); w.z = cvt_pk_bf16(v1[0], v1[1]); w.w = cvt_pk_bf16(v1[2], v1[3]); mk::wt16(R, ws, p, w); }
__device__ __forceinline__ float quad_sum(float s) { s += mk::xor_lane<16>(s); return mk::sum_xor32(s); }
__device__ __forceinline__ float row_rstd(const float* ssq, int row, int fq) {
    const f32x4 p = *(const f32x4*)(ssq + (size_t)row * 16 + 4 * fq);
    return rsqrtf(quad_sum((p[0] + p[1]) + (p[2] + p[3])) * (1.f / 1024.f) + EPS);
}
__device__ __forceinline__ void rows_rstd(const float* ssq, int row0, int fq, float (&rs)[2][4]) {
    f32x4 p[2][4];
#pragma unroll
    for (int ai = 0; ai < 2; ++ai)
#pragma unroll
        for (int m = 0; m < 4; ++m) p[ai][m] = *(const f32x4*)(ssq + (size_t)(row0 + ai * HALF + m * 16) * 16 + 4 * fq);
#pragma unroll
    for (int ai = 0; ai < 2; ++ai)
#pragma unroll
        for (int m = 0; m < 4; ++m) rs[ai][m] = rsqrtf(quad_sum((p[ai][m][0] + p[ai][m][1]) + (p[ai][m][2] + p[ai][m][3])) * (1.f / 1024.f) + EPS);
}
__device__ __forceinline__ float sumsq8(const f32x4 a, const f32x4 b) { return (a[0] * a[0] + a[1] * a[1]) + (a[2] * a[2] + a[3] * a[3]) + (b[0] * b[0] + b[1] * b[1]) + (b[2] * b[2] + b[3] * b[3]); }

struct EpBf16 {
    static constexpr bool PERM = true, AFTER_DRAIN = false;
    bf16_t* O; long ldc; unsigned char* ws;
    __device__ __forceinline__ void operator()(const f32x4 (&acc)[2][2][4][2], const Unit& u, int wr, int wc, int fr, int fq) const {
        asm volatile("" : "+v"(fr), "+v"(fq));
        const __amdgpu_buffer_rsrc_t R_ = mk::ws_rsrc(ws);
        if (ldc < 0) { asm volatile("" :: "v"(acc[0][0][0][0]), "v"(acc[1][1][3][1])); return; }
        const int row0 = u.pm * BM + wr * 64 + fr, col0 = u.pc * BM + wc * 32 + 8 * fq;
#pragma unroll
        for (int ai = 0; ai < 2; ++ai)
#pragma unroll
            for (int m = 0; m < 4; ++m) { bf16_t* rowp = O + (size_t)(row0 + ai * HALF + m * 16) * ldc + col0;
#pragma unroll
                for (int bj = 0; bj < 2; ++bj) store8(R_, ws, rowp + bj * HALF, acc[ai][bj][m][0], acc[ai][bj][m][1]); }
    }
};

struct EpIn0 {
    static constexpr bool PERM = true, AFTER_DRAIN = false;
    unsigned char* ws;
    __device__ __forceinline__ void operator()(const f32x4 (&acc)[2][2][4][2], const Unit& u, int wr, int wc, int fr, int fq) const {
        asm volatile("" : "+v"(fr), "+v"(fq));
        const __amdgpu_buffer_rsrc_t R_ = mk::ws_rsrc(ws);
        const float* ssq = (const float*)(ws + mk::ws_ssq(0)); bf16_t* Y = (bf16_t*)(ws + mk::WS_Y); bf16_t* VG = (bf16_t*)(ws + mk::WS_VG); float* gst = (float*)(ws + mk::WS_GST); bf16_t* KB = (bf16_t*)(ws + mk::WS_KB); bf16_t* VB = (bf16_t*)(ws + mk::WS_VB);
        const int pn = u.pn, row0 = u.pm * BM + wr * 64 + fr, cw = wc * 32 + 8 * fq;
        float rs8[2][4]; rows_rstd(ssq, row0, fq, rs8);
        f32x4 gv[2][2];
        if (pn >= 4 && pn < 8) { const float* g = pn < 6 ? mk::in_ptr(9) : mk::in_ptr(10);
#pragma unroll
            for (int bj = 0; bj < 2; ++bj)
#pragma unroll
                for (int n = 0; n < 2; ++n) { gv[bj][n] = *(const f32x4*)(g + 32 * bj + 8 * fq + 4 * n); if (pn < 6) gv[bj][n] = gv[bj][n] * C2; } }
#pragma unroll
        for (int ai = 0; ai < 2; ++ai)
#pragma unroll
            for (int m = 0; m < 4; ++m) {
                const int row = row0 + ai * HALF + m * 16;
                const float rs = rs8[ai][m];
                if (pn < 2) {
#pragma unroll
                    for (int bj = 0; bj < 2; ++bj) { f32x4 v0 = acc[ai][bj][m][0] * rs, v1 = acc[ai][bj][m][1] * rs;
#pragma unroll
                        for (int i = 0; i < 4; ++i) { v0[i] = fast_gelu_tanh(v0[i]); v1[i] = fast_gelu_tanh(v1[i]); }
                        store8(R_, ws, Y + (size_t)row * 1024 + pn * 256 + bj * HALF + cw, v0, v1); }
                } else if (pn < 4) {
                    float s = 0.f, q = 0.f;
#pragma unroll
                    for (int bj = 0; bj < 2; ++bj) { f32x4 v0 = acc[ai][bj][m][0] * rs, v1 = acc[ai][bj][m][1] * rs;
#pragma unroll
                        for (int i = 0; i < 4; ++i) { v0[i] = fast_gelu_tanh(v0[i]); v1[i] = fast_gelu_tanh(v1[i]); }
                        s += (v0[0] + v0[1]) + (v0[2] + v0[3]) + (v1[0] + v1[1]) + (v1[2] + v1[3]); q += sumsq8(v0, v1);
                        store8(R_, ws, VG + (size_t)row * 512 + (pn - 2) * 256 + bj * HALF + cw, v0, v1); }
                    s = quad_sum(s); q = quad_sum(q);
                    if (fq == 0) *(f32x2*)(gst + (size_t)row * 16 + ((pn - 2) * 4 + wc) * 2) = (f32x2){s, q};
                } else if (pn < 8) {
                    f32x4 v[2][2]; float ss = 0.f;
#pragma unroll
                    for (int bj = 0; bj < 2; ++bj) { v[bj][0] = acc[ai][bj][m][0] * rs; v[bj][1] = acc[ai][bj][m][1] * rs; ss += sumsq8(v[bj][0], v[bj][1]); }
                    const float hr = rsqrtf(quad_sum(ss) * (1.f / 64.f) + EPS);
                    const int head = (pn & 1) * 4 + wc;
                    bf16_t* dst = (pn < 6 ? Y + (size_t)row * 1024 + 512 : KB + (size_t)row * 512) + head * 64 + 8 * fq;
#pragma unroll
                    for (int bj = 0; bj < 2; ++bj) store8(R_, ws, dst + 32 * bj, v[bj][0] * hr * gv[bj][0], v[bj][1] * hr * gv[bj][1]);
                } else {
#pragma unroll
                    for (int bj = 0; bj < 2; ++bj) store8(R_, ws, VB + (size_t)row * 512 + (pn - 8) * 256 + bj * HALF + cw, acc[ai][bj][m][0] * rs, acc[ai][bj][m][1] * rs);
                }
            }
    }
};

struct EpIn1 {
    static constexpr bool PERM = true, AFTER_DRAIN = false;
    unsigned char* ws;
    __device__ __forceinline__ void operator()(const f32x4 (&acc)[2][2][4][2], const Unit& u, int wr, int wc, int fr, int fq) const {
        asm volatile("" : "+v"(fr), "+v"(fq));
        const __amdgpu_buffer_rsrc_t R_ = mk::ws_rsrc(ws);
        const float* ssq = (const float*)(ws + mk::ws_ssq(1)); bf16_t* Y = (bf16_t*)(ws + mk::WS_Y); bf16_t* K1 = (bf16_t*)(ws + mk::WS_KB); bf16_t* V1 = (bf16_t*)(ws + mk::WS_VB); bf16_t* HG = (bf16_t*)(ws + mk::WS_VG); const float* rope = (const float*)(ws + mk::WS_ROPE);
        const int pn = u.pn, row0 = u.pm * BM + wr * 64 + fr;
        float rs8[2][4]; rows_rstd(ssq, row0, fq, rs8);
        const bool isq = pn < 2, isk = (pn == 2 && wc < 2), isv = (pn == 2 && wc >= 2);
        f32x4 gv[2][2];
        if (isq || isk) { const float* g = isq ? mk::in_ptr(13) : mk::in_ptr(14);
#pragma unroll
            for (int bj = 0; bj < 2; ++bj)
#pragma unroll
                for (int n = 0; n < 2; ++n) { gv[bj][n] = *(const f32x4*)(g + 32 * bj + 8 * fq + 4 * n); if (isq) gv[bj][n] = gv[bj][n] * C2; } }
#pragma unroll
        for (int ai = 0; ai < 2; ++ai)
#pragma unroll
            for (int m = 0; m < 4; ++m) {
                const int row = row0 + ai * HALF + m * 16;
                const float rs = rs8[ai][m];
                if (pn < 3) {
                    f32x4 v[2][2]; float ss = 0.f;
#pragma unroll
                    for (int bj = 0; bj < 2; ++bj) { v[bj][0] = acc[ai][bj][m][0] * rs; v[bj][1] = acc[ai][bj][m][1] * rs; ss += sumsq8(v[bj][0], v[bj][1]); }
                    ss = quad_sum(ss);
                    if (!isv) {
                        const float hr = rsqrtf(ss * (1.f / 64.f) + EPS);
#pragma unroll
                        for (int bj = 0; bj < 2; ++bj) { v[bj][0] = v[bj][0] * hr * gv[bj][0]; v[bj][1] = v[bj][1] * hr * gv[bj][1]; }
                        const f32x4 c0 = *(const f32x4*)(rope + (size_t)(row & 2047) * 16), c1 = *(const f32x4*)(rope + (size_t)(row & 2047) * 16 + 4);
                        const f32x4 s0 = *(const f32x4*)(rope + (size_t)(row & 2047) * 16 + 8), s1 = *(const f32x4*)(rope + (size_t)(row & 2047) * 16 + 12);
                        f32x4 o0, o1;
#pragma unroll
                        for (int i = 0; i < 4; ++i) { o0[i] = mk::xor_lane<16>(v[0][0][i]); o1[i] = mk::xor_lane<16>(v[0][1][i]); }
                        if (fq == 0) { v[0][0] = v[0][0] * c0 - o0 * s0; v[0][1] = v[0][1] * c1 - o1 * s1; }
                        else if (fq == 1) { v[0][0] = v[0][0] * c0 + o0 * s0; v[0][1] = v[0][1] * c1 + o1 * s1; }
                    }
                    bf16_t* dst = isq ? Y + (size_t)row * 1024 + (pn * 4 + wc) * 64 : (isk ? K1 + (size_t)row * 128 + wc * 64 : V1 + (size_t)row * 128 + (wc - 2) * 64);
#pragma unroll
                    for (int bj = 0; bj < 2; ++bj) store8(R_, ws, dst + 32 * bj + 8 * fq, v[bj][0], v[bj][1]);
                } else {
                    f32x4 a0 = acc[ai][0][m][0] * rs, a1 = acc[ai][0][m][1] * rs; const f32x4 g0 = acc[ai][1][m][0] * rs, g1 = acc[ai][1][m][1] * rs;
#pragma unroll
                    for (int i = 0; i < 4; ++i) { a0[i] *= fast_sigmoid(g0[i]); a1[i] *= fast_sigmoid(g1[i]); }
                    store8(R_, ws, HG + (size_t)row * 512 + (pn - 3) * 128 + wc * 32 + 8 * fq, a0, a1);
                }
            }
    }
};

template <bool GATE> struct EpRes {
    static constexpr bool PERM = true, AFTER_DRAIN = false;
    float* out; unsigned char* ws; int layer;
    __device__ __forceinline__ void operator()(const f32x4 (&acc)[2][2][4][2], const Unit& u, int wr, int wc, int fr, int fq) const {
        asm volatile("" : "+v"(fr), "+v"(fq));
        const __amdgpu_buffer_rsrc_t R_ = mk::ws_rsrc(ws);
        const int lo_ = GATE ? (layer ^ 1) : layer; const bool fin = GATE && layer == 1;
        const bf16_t* res = (const bf16_t*)(ws + mk::ws_hb(layer)); bf16_t* hb = (bf16_t*)(ws + mk::ws_hb(lo_)); float* ssq_out = (float*)(ws + mk::ws_ssq(lo_)); const float* ssq_in = (const float*)(ws + mk::ws_ssq(layer)); const bf16_t* pp = (const bf16_t*)(ws + mk::WS_PP);
        const int row0 = u.pm * BM + wr * 64 + fr, col0 = u.pc * BM + wc * 32 + 8 * fq;
        float rs8[2][4];
        if (GATE) rows_rstd(ssq_in, row0, fq, rs8);
#pragma unroll
        for (int ap = 0; ap < 4; ++ap) {
            const int ai = ap >> 1, mb = (ap & 1) * 2;
            u32x4 rw[2][2], pw[2][2];
#pragma unroll
            for (int mm = 0; mm < 2; ++mm)
#pragma unroll
                for (int bj = 0; bj < 2; ++bj) { const size_t off = (size_t)(row0 + ai * HALF + (mb + mm) * 16) * 1024 + col0 + bj * HALF; rw[mm][bj] = *(const u32x4*)(res + off); if (GATE) pw[mm][bj] = __builtin_nontemporal_load((const u32x4*)(pp + off)); }
#pragma unroll
            for (int mm = 0; mm < 2; ++mm) {
                const int m = mb + mm;
                const int row = row0 + ai * HALF + m * 16; const size_t off = (size_t)row * 1024 + col0;
                const float rs = GATE ? rs8[ai][m] : 1.f;
                float ss = 0.f;
#pragma unroll
                for (int bj = 0; bj < 2; ++bj) {
                    f32x4 v0 = acc[ai][bj][m][0], v1 = acc[ai][bj][m][1];
                    const u32x4 r_ = rw[mm][bj];
                    const f32x4 r0 = {bf_lo(r_.x), bf_hi(r_.x), bf_lo(r_.y), bf_hi(r_.y)}, r1 = {bf_lo(r_.z), bf_hi(r_.z), bf_lo(r_.w), bf_hi(r_.w)};
                    if (GATE) { const u32x4 p_ = pw[mm][bj];
                        const f32x4 p0 = {bf_lo(p_.x), bf_hi(p_.x), bf_lo(p_.y), bf_hi(p_.y)}, p1 = {bf_lo(p_.z), bf_hi(p_.z), bf_lo(p_.w), bf_hi(p_.w)};
#pragma unroll
                        for (int i = 0; i < 4; ++i) { v0[i] = fast_sigmoid(v0[i] * rs) * p0[i]; v1[i] = fast_sigmoid(v1[i] * rs) * p1[i]; } }
                    v0 = v0 + r0; v1 = v1 + r1;
                    if (fin) { *(f32x4*)(out + off + bj * HALF) = v0; *(f32x4*)(out + off + bj * HALF + 4) = v1; }
                    else { store8(R_, ws, hb + off + bj * HALF, v0, v1); ss += sumsq8(v0, v1); }
                }
                if (!fin) { ss = quad_sum(ss); if (fq == 0) ssq_out[(size_t)row * 16 + u.pc * 4 + wc] = ss; }
            }
        }
    }
};

struct EpMoe1 {
    static constexpr bool PERM = true, AFTER_DRAIN = false;
    unsigned char* ws;
    __device__ __forceinline__ void operator()(const f32x4 (&acc)[2][2][4][2], const Unit& u, int wr, int wc, int fr, int fq) const {
        asm volatile("" : "+v"(fr), "+v"(fq));
        const __amdgpu_buffer_rsrc_t R_ = mk::ws_rsrc(ws);
        const float* rowrs = (const float*)(ws + mk::WS_ROWRS); const float* roww = (const float*)(ws + mk::WS_ROWW); bf16_t* HB = (bf16_t*)(ws + mk::WS_HID);
        const int row0 = u.pm * BM + wr * 64 + fr, col0 = u.pc * 128 + wc * 32 + 8 * fq;
        float rsv[2][4], wv[2][4];
#pragma unroll
        for (int ai = 0; ai < 2; ++ai)
#pragma unroll
            for (int m = 0; m < 4; ++m) { rsv[ai][m] = rowrs[row0 + ai * HALF + m * 16]; wv[ai][m] = roww[row0 + ai * HALF + m * 16]; }
#pragma unroll
        for (int ai = 0; ai < 2; ++ai)
#pragma unroll
            for (int m = 0; m < 4; ++m) {
                const int row = row0 + ai * HALF + m * 16; const float rs = rsv[ai][m], w = wv[ai][m];
                f32x4 g0 = acc[ai][0][m][0] * rs, g1 = acc[ai][0][m][1] * rs; const f32x4 u0 = acc[ai][1][m][0] * (rs * w), u1 = acc[ai][1][m][1] * (rs * w);
#pragma unroll
                for (int i = 0; i < 4; ++i) { g0[i] = fast_silu(g0[i]) * u0[i]; g1[i] = fast_silu(g1[i]) * u1[i]; }
                store8(R_, ws, HB + (size_t)row * 256 + col0, g0, g1);
            }
    }
};
template <class Epi, class Sched, bool ALIGN_EPI = false, bool SP2 = false, bool GATHER = false>
__device__ __forceinline__ void gemm_phase(PG8_LAS unsigned char* lds, const Gemm g, const Sched& S, const Epi& E, const int wave_id, const int* rowidx = nullptr) {
    static_assert(!GATHER || SP2, "GATHER is implemented for the SP2 loop only");
    int tid_ = wave_id * 64 + mk::lane_id(); asm volatile("" : "+v"(tid_));
    const int tid = tid_, wid = __builtin_amdgcn_readfirstlane(tid >> 6), lane = tid & 63, wr = wid >> 2, wc = wid & 3, fr = lane & 15, fq = lane >> 4;
    int K_ = g.K; asm volatile("" : "+s"(K_)); const int K = K_, nt = K / BK;
    unsigned voffA[2], voffB[2]; int gR[2], gC[2];
#pragma unroll
    for (int i = 0; i < 2; ++i) { int R, C; stage_rc(tid * 16 + i * 8192, R, C); const int Rb = Epi::PERM ? ((R & ~31) + perm32(R & 31)) : R; gR[i] = R; gC[i] = C;
        voffA[i] = (unsigned)(R * K + C) * 2u; voffB[i] = (unsigned)(Rb * K + C) * 2u; }
    unsigned cvo[2][2], nvo[2][2];
#define PG8_GVO(dst, u) do { _Pragma("unroll") for (int h_ = 0; h_ < 2; ++h_) _Pragma("unroll") for (int i_ = 0; i_ < 2; ++i_) \
        dst[h_][i_] = (unsigned)(rowidx[(u).pm * BM + h_ * HALF + gR[i_]] * K + gC[i_]) * 2u; } while (0)
    const size_t kstep = (size_t)(BK * 2);
    const size_t hstep = (size_t)HALF * K * 2;
    const size_t hstepA = GATHER ? 0 : hstep;
    const size_t tstep = 2 * hstep;
    const unsigned ldsw = (unsigned)wid * 1024u;
    const int aoff = lds_byte(wr * 64 + fr, fq * 8), boff = lds_byte(wc * 32 + fr, fq * 8);
#define PG8_SA(b, h) (((b) * 2 + (h)) * HTB)
#define PG8_SB(b, h) ((4 + (b) * 2 + (h)) * HTB)
#define PG8_STAGE(bufoff, gbase, voff) do { _Pragma("unroll") for (int _i = 0; _i < 2; ++_i) \
        __builtin_amdgcn_global_load_lds((const unsigned*)((const char*)(gbase) + (voff)[_i]), (PG8_LAS unsigned*)(lds + (bufoff) + ldsw + _i * 8192), 16, 0, 0); } while (0)
#define PG8_LDA(dst, b, h) do { _Pragma("unroll") for (int m = 0; m < 4; ++m) _Pragma("unroll") for (int k = 0; k < 2; ++k) dst[m][k] = *(const PG8_LAS bf16x8*)(lds + PG8_SA(b, h) + aoff + m * 2048 + k * 1024); } while (0)
#define PG8_LDB(dst, b, h) do { _Pragma("unroll") for (int n = 0; n < 2; ++n) _Pragma("unroll") for (int k = 0; k < 2; ++k) dst[n][k] = *(const PG8_LAS bf16x8*)(lds + PG8_SB(b, h) + boff + n * 2048 + k * 1024); } while (0)
#define PG8_MMA(ai, bj, At, Bt) do { __builtin_amdgcn_s_setprio(1); _Pragma("unroll") for (int m = 0; m < 4; ++m) _Pragma("unroll") for (int n = 0; n < 2; ++n) _Pragma("unroll") for (int k = 0; k < 2; ++k) \
        acc[ai][bj][m][n] = __builtin_amdgcn_mfma_f32_16x16x32_bf16(Bt[n][k], At[m][k], acc[ai][bj][m][n], 0, 0, 0); __builtin_amdgcn_s_setprio(0); } while (0)
#define PG8_WAIT_V(n) asm volatile("s_waitcnt vmcnt(" #n ")" ::: "memory")
#define PG8_WAIT_L(n) asm volatile("s_waitcnt lgkmcnt(" #n ")" ::: "memory")
#define PG8_BAR __builtin_amdgcn_s_barrier()
#define PG8_SCHED __builtin_amdgcn_sched_barrier(0)
    Unit cur, nxt; int ui = 0;
    if (!S.next(0, cur)) return;
    f32x4 acc[2][2][4][2];
#pragma unroll
    for (int a = 0; a < 2; ++a)
#pragma unroll
        for (int b = 0; b < 2; ++b)
#pragma unroll
            for (int m = 0; m < 4; ++m)
#pragma unroll
                for (int n = 0; n < 2; ++n) acc[a][b][m][n] = (f32x4){0.f, 0.f, 0.f, 0.f};
    bf16x8 At[4][2], B0[2][2], B1[2][2];
    const char* cA = (const char*)g.A + (GATHER ? 0 : (size_t)cur.pm * tstep); const char* cB = (const char*)g.Bt + (size_t)cur.pn * tstep;
    S.a_ready(cur);
    if constexpr (GATHER) { PG8_GVO(cvo, cur); } else { cvo[0][0] = cvo[1][0] = voffA[0]; cvo[0][1] = cvo[1][1] = voffA[1]; }
    if constexpr (SP2) {
        PG8_STAGE(PG8_SB(0, 0), cB, voffB); PG8_STAGE(PG8_SB(0, 1), cB + hstep, voffB); PG8_STAGE(PG8_SA(0, 0), cA, cvo[0]); PG8_STAGE(PG8_SA(0, 1), cA + hstepA, cvo[1]);
        if (wr == 1) PG8_BAR;
        PG8_WAIT_V(2); PG8_BAR;
        PG8_STAGE(PG8_SB(1, 0), cB + kstep, voffB); PG8_STAGE(PG8_SA(1, 0), cA + kstep, cvo[0]); PG8_STAGE(PG8_SB(1, 1), cB + hstep + kstep, voffB);
        PG8_WAIT_V(6); PG8_BAR;
    } else {
        PG8_STAGE(PG8_SB(0, 0), cB, voffB); PG8_STAGE(PG8_SA(0, 0), cA, voffA); PG8_STAGE(PG8_SB(0, 1), cB + hstep, voffB); PG8_STAGE(PG8_SA(0, 1), cA + hstep, voffA);
        if (wr == 1) PG8_BAR;
        PG8_WAIT_V(4); PG8_BAR;
        PG8_STAGE(PG8_SB(1, 0), cB + kstep, voffB); PG8_STAGE(PG8_SA(1, 0), cA + kstep, voffA); PG8_STAGE(PG8_SB(1, 1), cB + hstep + kstep, voffB);
        PG8_WAIT_V(6); PG8_BAR;
    }
    for (;;) {
        const bool has_next = S.next(ui + 1, nxt);
        const char* nA = (has_next && !GATHER) ? (const char*)g.A + (size_t)nxt.pm * tstep : cA; const char* nB = has_next ? (const char*)g.Bt + (size_t)nxt.pn * tstep : cB;
        if constexpr (GATHER) { if (has_next) { PG8_GVO(nvo, nxt); } else { nvo[0][0] = cvo[0][0]; nvo[0][1] = cvo[0][1]; nvo[1][0] = cvo[1][0]; nvo[1][1] = cvo[1][1]; } }
        else { nvo[0][0] = nvo[1][0] = voffA[0]; nvo[0][1] = nvo[1][1] = voffA[1]; }
        for (int t = 0; t < nt; t += 2) {
            const bool last = (t == nt - 2);
            const char* a1 = cA + (size_t)(t + 1) * kstep;
            const char* a2 = last ? nA : cA + (size_t)(t + 2) * kstep; const char* b2 = last ? nB : cB + (size_t)(t + 2) * kstep;
            const char* a3 = a2 + kstep; const char* b3 = b2 + kstep;
            if (last && has_next) S.a_ready(nxt);
            unsigned vo0[2], vo1[2];
            vo0[0] = last ? nvo[0][0] : cvo[0][0]; vo0[1] = last ? nvo[0][1] : cvo[0][1]; vo1[0] = last ? nvo[1][0] : cvo[1][0]; vo1[1] = last ? nvo[1][1] : cvo[1][1];
            if constexpr (SP2) {
            PG8_LDB(B0, 0, 0); PG8_LDB(B1, 0, 1); PG8_SCHED; PG8_LDA(At, 0, 0); PG8_STAGE(PG8_SA(1, 1), a1 + hstepA, cvo[1]);
            PG8_WAIT_V(8); PG8_WAIT_L(0); PG8_BAR; PG8_MMA(0, 0, At, B0); PG8_MMA(0, 1, At, B1); PG8_BAR; PG8_SCHED;
            PG8_LDA(At, 0, 1); PG8_STAGE(PG8_SB(0, 0), b2, voffB); PG8_STAGE(PG8_SB(0, 1), b2 + hstep, voffB); PG8_STAGE(PG8_SA(0, 0), a2, vo0);
            PG8_WAIT_V(8); PG8_WAIT_L(0); PG8_BAR; PG8_MMA(1, 0, At, B0); PG8_MMA(1, 1, At, B1); PG8_BAR; PG8_SCHED;
            PG8_LDB(B0, 1, 0); PG8_LDB(B1, 1, 1); PG8_SCHED; PG8_LDA(At, 1, 0); PG8_STAGE(PG8_SA(0, 1), a2 + hstepA, vo1);
            PG8_WAIT_V(8); PG8_WAIT_L(0); PG8_BAR; PG8_MMA(0, 0, At, B0); PG8_MMA(0, 1, At, B1); PG8_BAR; PG8_SCHED;
            PG8_LDA(At, 1, 1); PG8_STAGE(PG8_SB(1, 0), b3, voffB); PG8_STAGE(PG8_SB(1, 1), b3 + hstep, voffB); PG8_STAGE(PG8_SA(1, 0), a3, vo0);
            PG8_WAIT_V(8); PG8_WAIT_L(0); PG8_BAR; PG8_MMA(1, 0, At, B0); PG8_MMA(1, 1, At, B1); PG8_BAR; PG8_SCHED;
            } else {
            PG8_LDB(B0, 0, 0); PG8_SCHED; PG8_LDA(At, 0, 0); PG8_STAGE(PG8_SA(1, 1), a1 + hstep, voffA);
            PG8_WAIT_L(8); PG8_BAR; PG8_WAIT_L(0); PG8_MMA(0, 0, At, B0); PG8_BAR; PG8_SCHED;
            PG8_LDB(B1, 0, 1); PG8_STAGE(PG8_SB(0, 0), b2, voffB);
            PG8_BAR; PG8_WAIT_L(0); PG8_MMA(0, 1, At, B1); PG8_BAR;
            PG8_LDA(At, 0, 1); PG8_STAGE(PG8_SA(0, 0), a2, voffA);
            PG8_BAR; PG8_WAIT_L(0); PG8_MMA(1, 0, At, B0); PG8_BAR; PG8_SCHED;
            PG8_STAGE(PG8_SB(0, 1), b2 + hstep, voffB);
            PG8_WAIT_V(6); PG8_BAR; PG8_MMA(1, 1, At, B1); PG8_BAR;
            PG8_LDB(B0, 1, 0); PG8_SCHED; PG8_LDA(At, 1, 0); PG8_STAGE(PG8_SA(0, 1), a2 + hstep, voffA);
            PG8_WAIT_L(8); PG8_BAR; PG8_WAIT_L(0); PG8_MMA(0, 0, At, B0); PG8_BAR; PG8_SCHED;
            PG8_LDB(B1, 1, 1); PG8_STAGE(PG8_SB(1, 0), b3, voffB);
            PG8_BAR; PG8_WAIT_L(0); PG8_MMA(0, 1, At, B1); PG8_BAR;
            PG8_LDA(At, 1, 1); PG8_STAGE(PG8_SA(1, 0), a3, voffA);
            PG8_BAR; PG8_WAIT_L(0); PG8_MMA(1, 0, At, B0); PG8_BAR; PG8_SCHED;
            PG8_STAGE(PG8_SB(1, 1), b3 + hstep, voffB);
            PG8_WAIT_V(6); PG8_BAR; PG8_MMA(1, 1, At, B1); PG8_BAR;
            }
        }
        if constexpr (ALIGN_EPI) { if (wr == 0) PG8_BAR; }
        if constexpr (!Epi::AFTER_DRAIN) { E(acc, cur, wr, wc, fr, fq); S.done(cur); }
        if (!has_next) break;
#pragma unroll
        for (int a = 0; a < 2; ++a)
#pragma unroll
            for (int b = 0; b < 2; ++b)
#pragma unroll
                for (int m = 0; m < 4; ++m)
#pragma unroll
                    for (int n = 0; n < 2; ++n) acc[a][b][m][n] = (f32x4){0.f, 0.f, 0.f, 0.f};
        cur = nxt; cA = nA; cB = nB; ++ui;
        cvo[0][0] = nvo[0][0]; cvo[0][1] = nvo[0][1]; cvo[1][0] = nvo[1][0]; cvo[1][1] = nvo[1][1];
        if constexpr (ALIGN_EPI) { if (wr == 1) PG8_BAR; }
    }
    PG8_WAIT_V(0);
    if constexpr (!ALIGN_EPI) { if (wr == 0) PG8_BAR; }
    PG8_BAR;
    if constexpr (Epi::AFTER_DRAIN) { E.fused(acc, cur, wr, wc, fr, fq, lds, wid, lane); S.done(cur); }
#undef PG8_SA
#undef PG8_GVO
#undef PG8_SB
#undef PG8_STAGE
#undef PG8_LDA
#undef PG8_LDB
#undef PG8_MMA
#undef PG8_WAIT_V
#undef PG8_WAIT_L
#undef PG8_BAR
#undef PG8_SCHED
}
}
#ifndef PG8_SP2
#define PG8_SP2 true
#endif
#include <hip/hip_bf16.h>
namespace attn_body {
using bf16=__hip_bfloat16;
using bf16x8=__attribute__((ext_vector_type(8)))short;
using s16x4=__attribute__((ext_vector_type(4)))short;
using f32x16=__attribute__((ext_vector_type(16)))float;
using u32x4=__attribute__((ext_vector_type(4)))unsigned;
using f32x4v=__attribute__((ext_vector_type(4)))float;
constexpr int SEQ=2048,D=64;
constexpr int NW=8,QBLK=32,QB=QBLK*NW,KVBLK=64;
__device__ __forceinline__ int crow(int r,int hi){return (r&3)+8*(r>>2)+4*hi;}
#define SBAR() __builtin_amdgcn_sched_barrier(0)
__device__ __forceinline__ void cmask(f32x16&p0,f32x16&p1,int jb,int qrel,int hi){
  const float NEG=-INFINITY; int kb=64*jb+4*hi;
  #pragma unroll
  for(int r=0;r<16;++r){int kv=kb+(r&3)+8*(r>>2); if(kv>qrel)p0[r]=NEG; if(kv+32>qrel)p1[r]=NEG;}
}
constexpr int NSLOT=3, SLOTB=8192;
constexpr int LDS_K=0, LDS_V=NSLOT*SLOTB, LDS_WS=2*NSLOT*SLOTB, LDS_OST=LDS_WS+NW*64*4, LDS_CL=LDS_OST+NW*4096, LDS_RED=LDS_CL+SEQ*4, LDS_BYTES=LDS_RED+64;
__device__ __forceinline__ void glds16(const void*gsrc,unsigned lds_dst){unsigned keep;
  asm volatile("s_mov_b32 %0, m0\n\ts_mov_b32 m0, %2\n\ts_nop 0\n\tglobal_load_lds_dwordx4 %1, off\n\ts_mov_b32 m0, %0":"=&s"(keep):"v"(gsrc),"s"(lds_dst):"memory");}
__device__ __forceinline__ float max3f(float a,float b,float c){float r;asm("v_max3_f32 %0, %1, %2, %3":"=v"(r):"v"(a),"v"(b),"v"(c));return r;}
__device__ __forceinline__ float max2f(float a,float b){float r;asm("v_max_f32_e32 %0, %1, %2":"=v"(r):"v"(a),"v"(b));return r;}
__device__ __forceinline__ float fadd_s(float a,float b){float r;asm("v_add_f32_e32 %0, %1, %2":"=v"(r):"v"(a),"v"(b));return r;}
__device__ __forceinline__ float fsub_s(float a,float b){float r;asm("v_sub_f32_e32 %0, %1, %2":"=v"(r):"v"(a),"v"(b));return r;}
typedef float f32x2_t __attribute__((ext_vector_type(2))); typedef __bf16 bf16x2_t __attribute__((ext_vector_type(2)));
__device__ __forceinline__ unsigned cvtpk_s(float lo,float hi){f32x2_t v={lo,hi};bf16x2_t b=__builtin_convertvector(v,bf16x2_t);return __builtin_bit_cast(unsigned,b);}
#define WAIT_BAR(N) asm volatile("s_waitcnt vmcnt(" #N ") lgkmcnt(0)\n\ts_barrier":::"memory")

__device__ __forceinline__ void qkt(f32x16&p0,f32x16&p1,const char*Kslot,const bf16x8*qr,const f32x16&negm,int r32,int hi){
  const char*kb=Kslot+hi*1024+r32*16;
  #pragma unroll
  for(int d0=0;d0<4;++d0){
    const bf16x8 b0=*reinterpret_cast<const bf16x8*>(kb+d0*2048);
    const bf16x8 b1=*reinterpret_cast<const bf16x8*>(kb+d0*2048+512);
    if(d0==0){p0=__builtin_amdgcn_mfma_f32_32x32x16_bf16(b0,qr[0],negm,0,0,0);p1=__builtin_amdgcn_mfma_f32_32x32x16_bf16(b1,qr[0],negm,0,0,0);}
    else{p0=__builtin_amdgcn_mfma_f32_32x32x16_bf16(b0,qr[d0],p0,0,0,0);p1=__builtin_amdgcn_mfma_f32_32x32x16_bf16(b1,qr[d0],p1,0,0,0);}}
}
typedef __attribute__((address_space(3))) const char* lds_cptr;
typedef __attribute__((address_space(3))) const float* lds_fptr;
typedef short v4i16_t __attribute__((ext_vector_type(4)));
__device__ __forceinline__ void kload8(bf16x8*kf,lds_cptr kp){
  kf[0]=*(const __attribute__((address_space(3))) bf16x8*)(kp);      kf[1]=*(const __attribute__((address_space(3))) bf16x8*)(kp+512);
  kf[2]=*(const __attribute__((address_space(3))) bf16x8*)(kp+2048); kf[3]=*(const __attribute__((address_space(3))) bf16x8*)(kp+2560);
  kf[4]=*(const __attribute__((address_space(3))) bf16x8*)(kp+4096); kf[5]=*(const __attribute__((address_space(3))) bf16x8*)(kp+4608);
  kf[6]=*(const __attribute__((address_space(3))) bf16x8*)(kp+6144); kf[7]=*(const __attribute__((address_space(3))) bf16x8*)(kp+6656);
}
__device__ __forceinline__ void kload2(bf16x8*kf,lds_cptr kp,int j){ kf[2*j]=*(const __attribute__((address_space(3))) bf16x8*)(kp+j*2048); kf[2*j+1]=*(const __attribute__((address_space(3))) bf16x8*)(kp+j*2048+512); }
__device__ __forceinline__ s16x4 vtr(lds_cptr p){ return __builtin_bit_cast(s16x4,__builtin_amdgcn_ds_read_tr16_b64_v4i16((__attribute__((address_space(3))) v4i16_t*)p)); }
__device__ __forceinline__ float rowmax(const f32x16&p0,const f32x16&p1){
  float a=max3f(p0[0],p0[1],p1[0]),b=max3f(p0[2],p0[3],p1[1]);a=max3f(a,p1[2],p1[3]);
  #pragma unroll
  for(int r=4;r<16;r+=4){a=max3f(a,p0[r],p0[r+1]);b=max3f(b,p0[r+2],p0[r+3]);a=max3f(a,p1[r],p1[r+1]);b=max3f(b,p1[r+2],p1[r+3]);}
  const float m=max2f(a,b);
  auto rr=__builtin_amdgcn_permlane32_swap(__float_as_uint(m),__float_as_uint(m),false,false);
  return max2f(__uint_as_float(rr[0]),__uint_as_float(rr[1]));
}
__device__ __forceinline__ float rowmax_c(const f32x16&p0,const f32x16&p1){
  float a=fmaxf(p0[0],p1[0]);
  #pragma unroll
  for(int r=1;r<16;++r)a=fmaxf(a,fmaxf(p0[r],p1[r]));
  auto rr=__builtin_amdgcn_permlane32_swap(__float_as_uint(a),__float_as_uint(a),false,false);
  return fmaxf(__uint_as_float(rr[0]),__uint_as_float(rr[1]));
}
__device__ __forceinline__ void pv(f32x16*o,int vb,bf16x8 pa0,bf16x8 pa1,bf16x8 pa2,bf16x8 pa3){
  #pragma unroll
  for(int d0=0;d0<2;++d0){s16x4 lo[4],hi[4];
    #pragma unroll
    for(int ks=0;ks<4;++ks){
      asm volatile("ds_read_b64_tr_b16 %0,%1 offset:%c2":"=&v"(lo[ks]):"v"(vb),"i"(d0*4096+ks*1024):"memory");
      asm volatile("ds_read_b64_tr_b16 %0,%1 offset:%c2":"=&v"(hi[ks]):"v"(vb),"i"(d0*4096+ks*1024+512):"memory");}
    asm volatile("s_waitcnt lgkmcnt(0)":::"memory");SBAR();
    #define PK(k) (bf16x8){lo[k][0],lo[k][1],lo[k][2],lo[k][3],hi[k][0],hi[k][1],hi[k][2],hi[k][3]}
    o[d0]=__builtin_amdgcn_mfma_f32_32x32x16_bf16(pa0,PK(0),o[d0],0,0,0);
    o[d0]=__builtin_amdgcn_mfma_f32_32x32x16_bf16(pa1,PK(1),o[d0],0,0,0);
    o[d0]=__builtin_amdgcn_mfma_f32_32x32x16_bf16(pa2,PK(2),o[d0],0,0,0);
    o[d0]=__builtin_amdgcn_mfma_f32_32x32x16_bf16(pa3,PK(3),o[d0],0,0,0);
    #undef PK
  }
}
#define ATTN_STORE16(p,v) mk::wt16(mk::ws_rsrc(wsb),wsb,(p),(v))

__device__ __forceinline__ void fox_scan(int b,int h,const float*cfl,float bias,char*shm,int wv){
  int tid_=wv*64+mk::lane_id(); asm volatile("":"+v"(tid_)); const int tid=tid_,lane=tid&63,wid=tid>>6;
  float*cl=(float*)(shm+LDS_CL); float*red=(float*)(shm+LDS_RED);
  float v[4];
  #pragma unroll
  for(int i=0;i<4;++i){ const float x=cfl[((size_t)b*SEQ+4*tid+i)*8+h]+bias; v[i]=(fminf(x,0.f)-__logf(1.f+__expf(-fabsf(x))))*1.4426950408889634f; }
  v[1]+=v[0];v[2]+=v[1];v[3]+=v[2];
  float inc=v[3];
  #pragma unroll
  for(int o=1;o<64;o<<=1){ const float y=__builtin_bit_cast(float,__builtin_amdgcn_ds_bpermute(((lane-o)&63)*4,__builtin_bit_cast(int,inc))); if(lane>=o)inc+=y; }
  if(lane==63)red[wid]=inc;
  __syncthreads();
  float base=inc-v[3];
  for(int w=0;w<wid;++w)base+=red[w];
  #pragma unroll
  for(int i=0;i<4;++i)cl[4*tid+i]=base+v[i];
  __syncthreads();
}

template<int THRL,int QP,int KP> __device__ __forceinline__ void fox_unit(int b,int h,int qb,const bf16*Q,const bf16*__restrict__ K,const bf16*__restrict__ V,bf16*O,char*shm,int wv,const unsigned char*wsb){
  int tid_=wv*64+mk::lane_id(); asm volatile("":"+v"(tid_)); const int tid=tid_,lane=tid&63,r32=lane&31,hi=lane>>5; const int wid=__builtin_amdgcn_readfirstlane(tid>>6);
  const long rowbase=(long)b*SEQ; const int q0=qb*QB;
  const bf16*Qw=Q+(rowbase+q0+wid*QBLK)*QP+h*D;
  const bf16*Kh=K+rowbase*KP+h*D,*Vh=V+rowbase*KP+h*D;
  const unsigned lds0=(unsigned)(uintptr_t)shm;
  float*wsf=(float*)(shm+LDS_WS)+wid*64;
  const bf16*ksrc=Kh+(long)lane*KP+wid*8;
  const bf16*vsrc=Vh+(long)(16*(wid&3)+(lane>>2))*KP+(wid>>2)*32+(lane&3)*8;
  const unsigned kdst=lds0+LDS_K+wid*1024, vdst=lds0+LDS_V+wid*1024;
  #define DMA_K(t,slot) glds16(ksrc+(long)(t)*KVBLK*KP,(unsigned)__builtin_amdgcn_readfirstlane(kdst+(slot)))
  #define DMA_V(t,slot) glds16(vsrc+(long)(t)*KVBLK*KP,(unsigned)__builtin_amdgcn_readfirstlane(vdst+(slot)))
  const int vb0=(int)(lds0+LDS_V)+((lane>>4)&1)*32+(lane&3)*8+(4*hi+((lane&15)>>2))*64;
  const char*Kbase=shm+LDS_K; bf16x8 kf[8];
  const lds_cptr shm3=(lds_cptr)shm; const lds_cptr kp0=shm3+LDS_K+hi*1024+r32*16; const lds_cptr vp0=shm3+LDS_V+((lane>>4)&1)*32+(lane&3)*8+(4*hi+((lane&15)>>2))*64;
  const lds_fptr clp=(lds_fptr)(shm3+LDS_CL)+4*hi;
  const int NT=(q0+QB)/KVBLK;
  DMA_K(0,0);DMA_V(0,0);DMA_K(1,SLOTB);
  bf16x8 qr[4];
  #pragma unroll
  for(int d0=0;d0<4;++d0)qr[d0]=*reinterpret_cast<const bf16x8*>(&Qw[(long)r32*QP+d0*16+hi*8]);
  const float cq2=((lds_fptr)(shm3+LDS_CL))[q0+wid*QBLK+r32];
  float mhat=0.f,l_reg=0.f;f32x16 o[2];o[0]=f32x16{};o[1]=f32x16{};f32x16 negm;
  #pragma unroll
  for(int r=0;r<16;++r)negm[r]=cq2;
  asm volatile("":"+v"(negm));
  const int qrel=wid*QBLK+r32;
  #define LDF4(p) (*(const __attribute__((address_space(3))) f32x4v*)(p))
  #define CMASK(P0,P1,t) do{int jb_=(t)-(NT-4); if(jb_>=0)cmask(P0,P1,jb_,qrel,hi);}while(0)
  bool resc=false;
  #define START(P0,P1) do{ const float rm=fsub_s(rowmax(P0,P1),cq2); resc=false; \
    { const float dl=rm; mhat=fadd_s(mhat,dl); \
      _Pragma("unroll") for(int r=0;r<16;++r){P0[r]=fsub_s(P0[r],dl);P1[r]=fsub_s(P1[r],dl);} \
      _Pragma("unroll") for(int r=0;r<16;++r)negm[r]=cq2-mhat; asm volatile("":"+v"(negm)); } \
    _Pragma("unroll") for(int g_=0;g_<4;++g_){ const f32x4v k_=LDF4(clp+8*g_); _Pragma("unroll") for(int i_=0;i_<4;++i_)P0[4*g_+i_]=__builtin_amdgcn_exp2f(P0[4*g_+i_]-k_[i_]); } }while(0)
  #define RESC() do{ if(resc){ asm volatile("s_waitcnt lgkmcnt(0)":::"memory"); \
      _Pragma("unroll") for(int d_=0;d_<2;++d_) _Pragma("unroll") for(int r=0;r<16;++r)o[d_][r]*=wsf[crow(r,hi)]; } }while(0)
  f32x16 pA0,pA1,pB0,pB1;
  int sl_prev=0,sl_cur=0,sl_next=SLOTB;
  #define ROT() do{sl_prev=sl_cur;sl_cur=sl_next;sl_next=(sl_next==(NSLOT-1)*SLOTB)?0:sl_next+SLOTB;}while(0)
  DMA_K(2,2*SLOTB);
  WAIT_BAR(3);
  qkt(pA0,pA1,Kbase,qr,negm,r32,hi);asm volatile("s_nop 15\n\ts_nop 7":"+v"(pA0),"+v"(pA1));CMASK(pA0,pA1,0);
  START(pA0,pA1);
  _Pragma("unroll") for(int g_=0;g_<4;++g_){ const f32x4v k_=LDF4(clp+32+8*g_); _Pragma("unroll") for(int i_=0;i_<4;++i_)pA1[4*g_+i_]=__builtin_amdgcn_exp2f(pA1[4*g_+i_]-k_[i_]); }
  WAIT_BAR(0);
  DMA_K(3,0);DMA_V(1,SLOTB);
  ROT();
  kload8(kf,kp0+sl_cur);
  WAIT_BAR(2);
  s16x4 vlo[8],vhi[8]; u32x4 pw0,pw1,pw2,pw3;
  #define PKW(P,B) cvtpk_s(P[B],P[B+1])
  #define PAF(k) __builtin_bit_cast(bf16x8,pw##k)
  #define VFR(i) (bf16x8){vlo[i][0],vlo[i][1],vlo[i][2],vlo[i][3],vhi[i][0],vhi[i][1],vhi[i][2],vhi[i][3]}
  #define PIN(x) asm volatile("":"+v"(x))
  #define MX3(a,b,c) __builtin_fmaxf(__builtin_fmaxf((a),(b)),(c))
  #define GAPA(MF,A0,A1,A2,A3,W0,W1,PW) do{ MF; sacc+=A0; sacc+=A1; sacc+=A2; sacc+=A3; PIN(sacc); W0; W1; PIN(PW); SBAR(); }while(0)
  #define EX(v) __builtin_amdgcn_exp2f(v)
  #define GAPB(MF,X,B,OFFN) do{ const f32x4v kn_=LDF4(cbt_+(OFFN)); MF; X[B]=EX(X[B]-kc_[0]); X[B+1]=EX(X[B+1]-kc_[1]); X[B+2]=EX(X[B+2]-kc_[2]); X[B+3]=EX(X[B+3]-kc_[3]); kc_=kn_; PIN(X); SBAR(); }while(0)
  #define VRD(i) do{ vlo[i]=vtr(vp_+(((i)>>2)*4096+((i)&3)*1024)); vhi[i]=vtr(vp_+(((i)>>2)*4096+((i)&3)*1024+512)); }while(0)
  #define KRD(G,j) do{ if(G){ kload2(kf,kp0+sl_next,j); SBAR(); } }while(0)
  #define STEP(C0,C1,P0,P1,t,GK,GV,GL) do{ SBAR(); \
    const lds_cptr vp_=vp0+sl_prev; const lds_fptr cbt_=clp+64*(t); \
    VRD(0); SBAR(); float sacc=(P0[0]+P0[1]); \
    GAPA(C0=__builtin_amdgcn_mfma_f32_32x32x16_bf16(kf[0],qr[0],negm,0,0,0), P0[2],P0[3],P0[4],P0[5],     pw0[0]=PKW(P0,0), pw0[1]=PKW(P0,2), pw0); \
    VRD(4); SBAR(); GAPA(C1=__builtin_amdgcn_mfma_f32_32x32x16_bf16(kf[1],qr[0],negm,0,0,0), P0[6],P0[7],P0[8],P0[9],     pw0[2]=PKW(P0,4), pw0[3]=PKW(P0,6), pw0); \
    VRD(1); SBAR(); GAPA(C0=__builtin_amdgcn_mfma_f32_32x32x16_bf16(kf[2],qr[1],C0,0,0,0),   P0[10],P0[11],P0[12],P0[13], pw1[0]=PKW(P0,8), pw1[1]=PKW(P0,10), pw1); \
    VRD(5); SBAR(); GAPA(C1=__builtin_amdgcn_mfma_f32_32x32x16_bf16(kf[3],qr[1],C1,0,0,0),   P0[14],P0[15],P1[0],P1[1],   pw1[2]=PKW(P0,12),pw1[3]=PKW(P0,14), pw1); \
    VRD(2); SBAR(); GAPA(C0=__builtin_amdgcn_mfma_f32_32x32x16_bf16(kf[4],qr[2],C0,0,0,0),   P1[2],P1[3],P1[4],P1[5],     pw2[0]=PKW(P1,0), pw2[1]=PKW(P1,2), pw2); \
    VRD(6); SBAR(); GAPA(C1=__builtin_amdgcn_mfma_f32_32x32x16_bf16(kf[5],qr[2],C1,0,0,0),   P1[6],P1[7],P1[8],P1[9],     pw2[2]=PKW(P1,4), pw2[3]=PKW(P1,6), pw2); \
    VRD(3); SBAR(); GAPA(C0=__builtin_amdgcn_mfma_f32_32x32x16_bf16(kf[6],qr[3],C0,0,0,0),   P1[10],P1[11],P1[12],P1[13], pw3[0]=PKW(P1,8), pw3[1]=PKW(P1,10), pw3); \
    VRD(7); SBAR(); GAPA(C1=__builtin_amdgcn_mfma_f32_32x32x16_bf16(kf[7],qr[3],C1,0,0,0),   P1[14],P1[15],0.f,0.f,       pw3[2]=PKW(P1,12),pw3[3]=PKW(P1,14), pw3); \
    l_reg+=sacc; \
    if(GK){DMA_K((t)+3,sl_cur);} if(GV){DMA_V((t)+1,sl_next);} \
    CMASK(C0,C1,t); \
    f32x4v kc_=LDF4(cbt_); \
    { float a=MX3(C0[0],C0[1],C1[0]),b=MX3(C0[2],C0[3],C1[1]); a=MX3(a,C1[2],C1[3]); \
      _Pragma("unroll") for(int r=4;r<16;r+=4){a=MX3(a,C0[r],C0[r+1]);b=MX3(b,C0[r+2],C0[r+3]);a=MX3(a,C1[r],C1[r+1]);b=MX3(b,C1[r+2],C1[r+3]);} \
      float rm=__builtin_fmaxf(a,b); { auto rr=__builtin_amdgcn_permlane32_swap(__float_as_uint(rm),__float_as_uint(rm),false,false); rm=__builtin_fmaxf(__uint_as_float(rr[0]),__uint_as_float(rr[1]))-cq2; } \
      resc=false; \
      if(__builtin_expect(__any(rm>(float)THRL),0)){ const float dl=__builtin_fmaxf(rm,0.f); mhat+=dl; \
        _Pragma("unroll") for(int r=0;r<16;++r){C0[r]-=dl;C1[r]-=dl;} \
        _Pragma("unroll") for(int r=0;r<16;++r)negm[r]=cq2-mhat; asm volatile("":"+v"(negm)); \
        const float f=__builtin_amdgcn_exp2f(-dl); l_reg*=f; if(hi==0)wsf[r32]=f; resc=true; } } \
    SBAR(); \
    GAPB(o[0]=__builtin_amdgcn_mfma_f32_32x32x16_bf16(PAF(0),VFR(0),o[0],0,0,0), C0,0,8); \
    GAPB(o[1]=__builtin_amdgcn_mfma_f32_32x32x16_bf16(PAF(0),VFR(4),o[1],0,0,0), C0,4,16); \
    KRD(GL,0); GAPB(o[0]=__builtin_amdgcn_mfma_f32_32x32x16_bf16(PAF(1),VFR(1),o[0],0,0,0), C0,8,24); \
    KRD(GL,1); GAPB(o[1]=__builtin_amdgcn_mfma_f32_32x32x16_bf16(PAF(1),VFR(5),o[1],0,0,0), C0,12,32); \
    KRD(GL,2); GAPB(o[0]=__builtin_amdgcn_mfma_f32_32x32x16_bf16(PAF(2),VFR(2),o[0],0,0,0), C1,0,40); \
    KRD(GL,3); GAPB(o[1]=__builtin_amdgcn_mfma_f32_32x32x16_bf16(PAF(2),VFR(6),o[1],0,0,0), C1,4,48); \
    GAPB(o[0]=__builtin_amdgcn_mfma_f32_32x32x16_bf16(PAF(3),VFR(3),o[0],0,0,0), C1,8,56); \
    GAPB(o[1]=__builtin_amdgcn_mfma_f32_32x32x16_bf16(PAF(3),VFR(7),o[1],0,0,0), C1,12,0); \
    }while(0)
  int t=1;
  #undef CMASK
  #define CMASK(P0,P1,t) do{}while(0)
  for(;t+5<NT;t+=2){
    STEP(pB0,pB1,pA0,pA1,t,true,true,true);     WAIT_BAR(2); RESC(); ROT();
    STEP(pA0,pA1,pB0,pB1,t+1,true,true,true);   WAIT_BAR(2); RESC(); ROT();
  }
  #undef CMASK
  #define CMASK(P0,P1,t) do{int jb_=(t)-(NT-4); if(jb_>=0)cmask(P0,P1,jb_,qrel,hi);}while(0)
  #define ENDW(tt) do{ if((tt)+3<NT){WAIT_BAR(2);} else if((tt)+2<NT){WAIT_BAR(1);} else {WAIT_BAR(0);} }while(0)
  for(;t+1<NT;t+=2){
    STEP(pB0,pB1,pA0,pA1,t,(t+3<NT),(t+1<NT),(t+1<NT));       ENDW(t);   RESC(); ROT();
    STEP(pA0,pA1,pB0,pB1,t+1,(t+4<NT),(t+2<NT),(t+2<NT));     ENDW(t+1); RESC(); ROT();
  }
  STEP(pB0,pB1,pA0,pA1,NT-1,false,false,false); RESC();
  { float sacc=pB0[0]+pB0[1]; _Pragma("unroll") for(int r=2;r<16;++r)sacc+=pB0[r]; _Pragma("unroll") for(int r=0;r<16;++r)sacc+=pB1[r]; l_reg+=sacc;
    pw0=(u32x4){PKW(pB0,0),PKW(pB0,2),PKW(pB0,4),PKW(pB0,6)};pw1=(u32x4){PKW(pB0,8),PKW(pB0,10),PKW(pB0,12),PKW(pB0,14)};pw2=(u32x4){PKW(pB1,0),PKW(pB1,2),PKW(pB1,4),PKW(pB1,6)};pw3=(u32x4){PKW(pB1,8),PKW(pB1,10),PKW(pB1,12),PKW(pB1,14)};
    SBAR(); pv(o,vb0+sl_cur,PAF(0),PAF(1),PAF(2),PAF(3)); }
  #undef GAPA
  #undef GAPB
  #undef EX
  #undef VRD
  #undef KRD
  #undef STEP
  #undef ENDW
  #undef LDF4
  {auto rr=__builtin_amdgcn_permlane32_swap(__float_as_uint(l_reg),__float_as_uint(l_reg),false,false);l_reg=__uint_as_float(rr[0])+__uint_as_float(rr[1]);}
  if(hi==0)wsf[32+r32]=l_reg;asm volatile("s_waitcnt lgkmcnt(0)":::"memory");
  float rli[16];
  #pragma unroll
  for(int r=0;r<16;++r)rli[r]=__builtin_amdgcn_rcpf(wsf[32+crow(r,hi)]);
  bf16*Ow=O+(rowbase+q0+wid*QBLK)*QP+h*D;
  { bf16*stg=(bf16*)(shm+LDS_OST)+wid*2048;
    #pragma unroll
    for(int r=0;r<16;++r){const int orow=crow(r,hi);
      #pragma unroll
      for(int d0=0;d0<2;++d0)stg[orow*64+d0*32+r32]=__float2bfloat16(o[d0][r]*rli[r]);}
    asm volatile("s_waitcnt lgkmcnt(0)":::"memory");
    #pragma unroll
    for(int i=0;i<4;++i){const int row=i*8+(lane>>3),ch=lane&7; const u32x4 v=*(const u32x4*)(stg+row*64+ch*8); ATTN_STORE16(Ow+(long)row*QP+ch*8,v);} }
  asm volatile("s_waitcnt lgkmcnt(0)\n\ts_barrier":::"memory");
  #undef DMA_K
  #undef DMA_V
  #undef CMASK
  #undef START
  #undef RESC
  #undef ROT
}

template<int QP,int KP> __device__ __forceinline__ void swa_unit(int b,int kvh,int qb,const bf16*Q,const bf16*__restrict__ K,const bf16*__restrict__ V,bf16*O,const float*sinks,char*shm,int wv,const unsigned char*wsb){
  int tid_=wv*64+mk::lane_id(); asm volatile("":"+v"(tid_)); const int tid=tid_,lane=tid&63,r32=lane&31,hi=lane>>5; const int wid=__builtin_amdgcn_readfirstlane(tid>>6);
  const long rowbase=(long)b*SEQ; const int q0=qb*64; const int head=kvh*4+(wid>>1); const int qw=q0+32*(wid&1);
  const bf16*Qw=Q+(rowbase+qw)*QP+head*D;
  const bf16*Kh=K+rowbase*KP+kvh*D,*Vh=V+rowbase*KP+kvh*D;
  const unsigned lds0=(unsigned)(uintptr_t)shm;
  float*wsf=(float*)(shm+LDS_WS)+wid*64;
  const bf16*ksrc=Kh+(long)lane*KP+wid*8;
  const bf16*vsrc=Vh+(long)(16*(wid&3)+(lane>>2))*KP+(wid>>2)*32+(lane&3)*8;
  const unsigned kdst=lds0+LDS_K+wid*1024, vdst=lds0+LDS_V+wid*1024;
  const int vb0=(int)(lds0+LDS_V)+((lane>>4)&1)*32+(lane&3)*8+(4*hi+((lane&15)>>2))*64;
  const int tlo=qb>=2?qb-2:0, NT=qb-tlo+1;
  for(int j=0;j<NT;++j){ glds16(ksrc+(long)(tlo+j)*KVBLK*KP,(unsigned)__builtin_amdgcn_readfirstlane(kdst+j*SLOTB)); glds16(vsrc+(long)(tlo+j)*KVBLK*KP,(unsigned)__builtin_amdgcn_readfirstlane(vdst+j*SLOTB)); }
  bf16x8 qr[4];
  #pragma unroll
  for(int d0=0;d0<4;++d0)qr[d0]=*reinterpret_cast<const bf16x8*>(&Qw[(long)r32*QP+d0*16+hi*8]);
  float mhat=sinks[head]*1.4426950408889634f, l_reg=(hi==0)?1.f:0.f; f32x16 o[2];o[0]=f32x16{};o[1]=f32x16{};
  WAIT_BAR(0);
  const int qabs=qw+r32;
  for(int j=0;j<NT;++j){
    f32x16 negm;
    #pragma unroll
    for(int r=0;r<16;++r)negm[r]=-mhat;
    f32x16 p0,p1; qkt(p0,p1,shm+LDS_K+j*SLOTB,qr,negm,r32,hi);
    const int kb=64*(tlo+j)+4*hi;
    #pragma unroll
    for(int r=0;r<16;++r){ const int kv=kb+(r&3)+8*(r>>2); if(kv>qabs||kv<=qabs-128)p0[r]=-INFINITY; if(kv+32>qabs||kv+32<=qabs-128)p1[r]=-INFINITY; }
    const float rm=rowmax_c(p0,p1);
    if(__any(rm>0.f)){ const float dl=fmaxf(rm,0.f); mhat+=dl;
      #pragma unroll
      for(int r=0;r<16;++r){p0[r]-=dl;p1[r]-=dl;}
      const float f=__builtin_amdgcn_exp2f(-dl); l_reg*=f; if(hi==0)wsf[r32]=f;
      asm volatile("s_waitcnt lgkmcnt(0)":::"memory");
      #pragma unroll
      for(int d_=0;d_<2;++d_)
        #pragma unroll
        for(int r=0;r<16;++r)o[d_][r]*=wsf[crow(r,hi)];
    }
    float sacc=0.f;
    #pragma unroll
    for(int r=0;r<16;++r){p0[r]=__builtin_amdgcn_exp2f(p0[r]);p1[r]=__builtin_amdgcn_exp2f(p1[r]);sacc+=p0[r]+p1[r];}
    l_reg+=sacc;
    u32x4 pw0,pw1,pw2,pw3;
    pw0=(u32x4){cvtpk_s(p0[0],p0[1]),cvtpk_s(p0[2],p0[3]),cvtpk_s(p0[4],p0[5]),cvtpk_s(p0[6],p0[7])};
    pw1=(u32x4){cvtpk_s(p0[8],p0[9]),cvtpk_s(p0[10],p0[11]),cvtpk_s(p0[12],p0[13]),cvtpk_s(p0[14],p0[15])};
    pw2=(u32x4){cvtpk_s(p1[0],p1[1]),cvtpk_s(p1[2],p1[3]),cvtpk_s(p1[4],p1[5]),cvtpk_s(p1[6],p1[7])};
    pw3=(u32x4){cvtpk_s(p1[8],p1[9]),cvtpk_s(p1[10],p1[11]),cvtpk_s(p1[12],p1[13]),cvtpk_s(p1[14],p1[15])};
    SBAR(); pv(o,vb0+j*SLOTB,__builtin_bit_cast(bf16x8,pw0),__builtin_bit_cast(bf16x8,pw1),__builtin_bit_cast(bf16x8,pw2),__builtin_bit_cast(bf16x8,pw3));
  }
  {auto rr=__builtin_amdgcn_permlane32_swap(__float_as_uint(l_reg),__float_as_uint(l_reg),false,false);l_reg=__uint_as_float(rr[0])+__uint_as_float(rr[1]);}
  if(hi==0)wsf[32+r32]=l_reg;asm volatile("s_waitcnt lgkmcnt(0)":::"memory");
  float rli[16];
  #pragma unroll
  for(int r=0;r<16;++r)rli[r]=__builtin_amdgcn_rcpf(wsf[32+crow(r,hi)]);
  bf16*Ow=O+(rowbase+qw)*QP+head*D;
  { bf16*stg=(bf16*)(shm+LDS_OST)+wid*2048;
    #pragma unroll
    for(int r=0;r<16;++r){const int orow=crow(r,hi);
      #pragma unroll
      for(int d0=0;d0<2;++d0)stg[orow*64+d0*32+r32]=__float2bfloat16(o[d0][r]*rli[r]);}
    asm volatile("s_waitcnt lgkmcnt(0)":::"memory");
    #pragma unroll
    for(int i=0;i<4;++i){const int row=i*8+(lane>>3),ch=lane&7; const u32x4 v=*(const u32x4*)(stg+row*64+ch*8); ATTN_STORE16(Ow+(long)row*QP+ch*8,v);} }
  asm volatile("s_waitcnt lgkmcnt(0)\n\ts_barrier":::"memory");
}
#undef SBAR
#undef WAIT_BAR
}
namespace mk {
#define GAS __attribute__((address_space(1)))
#define LAS __attribute__((address_space(3)))
typedef unsigned short bf16;
typedef unsigned v4u __attribute__((ext_vector_type(4)));
typedef unsigned v2u __attribute__((ext_vector_type(2)));
typedef float f32x4 __attribute__((ext_vector_type(4)));
typedef float f32x2 __attribute__((ext_vector_type(2)));
typedef float f32x16 __attribute__((ext_vector_type(16)));
typedef short bf16x8 __attribute__((ext_vector_type(8)));
typedef GAS unsigned gu32;
typedef GAS unsigned long long gu64;
#define RLX_AGENT __ATOMIC_RELAXED, __HIP_MEMORY_SCOPE_AGENT
#define LDS_WAIT() asm volatile("s_waitcnt lgkmcnt(0)" ::: "memory")
#define VM_WAIT() asm volatile("s_waitcnt vmcnt(0)" ::: "memory")
using pg8::cvt_pk_bf16; using pg8::bf_lo; using pg8::bf_hi;
__device__ __forceinline__ unsigned pk2(float lo, float hi) { return cvt_pk_bf16(lo, hi); }

#define XB_TMO      128
#define XB_XCNT(j)  (256  + 64 * (j))
#define XB_XSUB(j)  (1280 + 64 * (j))
#define XB_XGEN(j)  (2304 + 64 * (j))
#define XB_TOP      3328
#define XB_TOPGEN   3392
#define XCD_BAR_WORDS 3456
#define XB_SPIN_CAP (1u << 18)

__device__ __forceinline__ unsigned xb_ld(unsigned* p)              { return __hip_atomic_load(p, __ATOMIC_RELAXED, __HIP_MEMORY_SCOPE_AGENT); }
__device__ __forceinline__ unsigned xb_add(unsigned* p, unsigned v) { return __hip_atomic_fetch_add(p, v, __ATOMIC_RELAXED, __HIP_MEMORY_SCOPE_AGENT); }
__device__ __forceinline__ unsigned xb_xcc_id() { return (unsigned)__builtin_amdgcn_s_getreg((3 << 11) | 20) & 0xFu; }
#define XB_SPIN(cond, bar) do { unsigned _sp = 0; while (cond) { __builtin_amdgcn_s_sleep(1); \
    if ((++_sp & 255u) == 0u) { if (xb_ld(&(bar)[XB_TMO])) break; if (_sp > XB_SPIN_CAP) { atomicAdd(&(bar)[XB_TMO], 1u); break; } } } } while (0)

struct XcdBarrier {
    unsigned* bar; unsigned x;
    volatile LAS unsigned* st;
};

__device__ __forceinline__ XcdBarrier xcd_barrier_post(unsigned* bar, volatile LAS unsigned* st) {
    XcdBarrier b; b.bar = bar; b.x = xb_xcc_id(); b.st = st;
    if (threadIdx.x == 0) (void)xb_add(&bar[XB_XCNT(b.x)], 1u);
    return b;
}
__device__ __forceinline__ void xcd_barrier_complete(unsigned* bar, unsigned x, unsigned& nloc, unsigned& nx) {
    const unsigned G = gridDim.x * gridDim.y * gridDim.z;
    unsigned sum, cnt, mine, sp = 0u;
    for (;;) {
        sum = 0u; cnt = 0u; mine = 0u;
#pragma unroll
        for (unsigned j = 0; j < 16; ++j) { const unsigned c = xb_ld(&bar[XB_XCNT(j)]); sum += c; cnt += (c > 0u) ? 1u : 0u; mine = (j == x) ? c : mine; }
        if (sum == G) break;
        __builtin_amdgcn_s_sleep(1);
        if ((++sp & 255u) == 0u) { if (xb_ld(&bar[XB_TMO])) break; if (sp > XB_SPIN_CAP) { atomicAdd(&bar[XB_TMO], 1u); break; } }
    }
    nloc = mine > 0u ? mine : 1u; nx = cnt > 0u ? cnt : 1u;
}

__device__ __forceinline__ void xcd_barrier(const XcdBarrier& b) {
    asm volatile("s_waitcnt vmcnt(0)" ::: "memory");
    __syncthreads();
    if (threadIdx.x == 0) {
        unsigned* bar = b.bar;
        __builtin_amdgcn_s_waitcnt(0);
        unsigned nloc = b.st[0], nx = b.st[1];
        if (nloc == 0u) { xcd_barrier_complete(bar, b.x, nloc, nx); b.st[0] = nloc; b.st[1] = nx; }
        const unsigned old = xb_add(&bar[XB_XSUB(b.x)], 1u);
        const unsigned gen = old / nloc;
        if (old + 1u == (gen + 1u) * nloc) {
            __builtin_amdgcn_fence(__ATOMIC_RELEASE, "agent");
            asm volatile("s_waitcnt vmcnt(0)" ::: "memory");
            const unsigned og = xb_add(&bar[XB_TOP], 1u);
            const unsigned tg = og / nx;
            if (og + 1u == (tg + 1u) * nx) xb_add(&bar[XB_TOPGEN], 1u);
            else XB_SPIN(xb_ld(&bar[XB_TOPGEN]) == tg, bar);
            __builtin_amdgcn_fence(__ATOMIC_ACQUIRE, "agent");
            xb_add(&bar[XB_XGEN(b.x)], 1u);
            asm volatile("s_waitcnt vmcnt(0)" ::: "memory");
        } else {
            XB_SPIN(xb_ld(&bar[XB_XGEN(b.x)]) == gen, bar);
            __builtin_amdgcn_fence(__ATOMIC_ACQUIRE, "agent");
            asm volatile("s_waitcnt vmcnt(0)" ::: "memory");
        }
    }
    __syncthreads();
}


struct Args { const float* in[31]; float* out; unsigned char* ws; const float* prep_src; int ph_lo, ph_hi, flags, li, prep_layer, pad; };

__device__ __forceinline__ float wave_sum(float v) { return wave_sum64(v); }

struct TItem { const float* src; bf16* dst; const float* gs; int ld, k0, c0, dstK, drow0; };
__device__ __forceinline__ void titem_load(const TItem& d, float (&r)[32], int lane) {
    const float* p = d.src + (size_t)(d.k0 + (lane >> 5)) * d.ld + d.c0 + (lane & 31);
#pragma unroll
    for (int i = 0; i < 32; ++i) r[i] = __builtin_nontemporal_load(p + (size_t)(2 * i) * d.ld);
}
__device__ __forceinline__ void titem_finish(const TItem& d, const float (&r)[32], LAS float* scr, int lane, const unsigned char* ws) {
    const __amdgpu_buffer_rsrc_t R_ = ws_rsrc(ws);
#pragma unroll
    for (int i = 0; i < 32; ++i) scr[(2 * i + (lane >> 5)) * 33 + (lane & 31)] = r[i];
    const int c = lane & 7;
    f32x4 g0 = {1.f, 1.f, 1.f, 1.f}, g1 = {1.f, 1.f, 1.f, 1.f};
    if (d.gs) { g0 = *(const f32x4*)(d.gs + d.k0 + 8 * c); g1 = *(const f32x4*)(d.gs + d.k0 + 8 * c + 4); }
    LDS_WAIT(); asm volatile("" ::: "memory");
#pragma unroll
    for (int j = 0; j < 4; ++j) { const int n = (lane >> 3) + 8 * j; const LAS float* s = scr + (8 * c) * 33 + n;
        v4u o; o.x = pk2(s[0 * 33] * g0.x, s[1 * 33] * g0.y); o.y = pk2(s[2 * 33] * g0.z, s[3 * 33] * g0.w); o.z = pk2(s[4 * 33] * g1.x, s[5 * 33] * g1.y); o.w = pk2(s[6 * 33] * g1.z, s[7 * 33] * g1.w);
        wt16c(R_, ws, d.dst + (size_t)(d.drow0 + n) * d.dstK + d.k0 + 8 * c, o); }
    LDS_WAIT(); asm volatile("" ::: "memory");
}
__device__ __forceinline__ int head_perm(int c) { const int t = c & ~255, l = c & 255; return t + 128 * ((l >> 5) & 1) + 32 * (l >> 6) + (l & 31); }

__device__ __forceinline__ void row_prep(const float* src, bf16* hb, float* ssq, int lane, f32x4 (&v)[4]) {
    const GAS f32x4* xr = (const GAS f32x4*)src + 4 * lane;
    float s = 0.f;
#pragma unroll
    for (int j = 0; j < 4; ++j) { v[j] = xr[j]; s += (v[j].x * v[j].x + v[j].y * v[j].y) + (v[j].z * v[j].z + v[j].w * v[j].w); }
    v4u o0, o1; o0.x = pk2(v[0].x, v[0].y); o0.y = pk2(v[0].z, v[0].w); o0.z = pk2(v[1].x, v[1].y); o0.w = pk2(v[1].z, v[1].w);
    o1.x = pk2(v[2].x, v[2].y); o1.y = pk2(v[2].z, v[2].w); o1.z = pk2(v[3].x, v[3].y); o1.w = pk2(v[3].z, v[3].w);
    GAS v4u* o = (GAS v4u*)hb + 2 * lane; o[0] = o0; o[1] = o1;
    s += xor_lane<1>(s); s += xor_lane<2>(s);
    if ((lane & 3) == 0) ssq[lane >> 2] = s;
}

struct Frame {
    LAS unsigned char* lds; gu32* ctl; unsigned char* ws;
    int tid, lane, wave, vcu, G;
    float* out;
};
#define WSP(T_, off) ((T_*)(F.ws + (off)))
#define IN(i) (in_ptr(i))

constexpr int I_IN0 = 16 * 80, I_SQ = 16 * 32, I_IN1 = 16 * 56, I_PP = 4 * 32, I_MG = 32 * 16 * 8, I_MD = 32 * 4 * 32;
constexpr int Q_IN0 = 0, Q_OUT0 = Q_IN0 + I_IN0, Q_PP0 = Q_OUT0 + I_SQ, Q_G0 = Q_PP0 + I_PP, Q_U0 = Q_G0 + I_MG, Q_D0 = Q_U0 + I_MG, Q_PG0 = Q_D0 + I_MD,
              Q_IN1 = Q_PG0 + I_SQ, Q_OUT1 = Q_IN1 + I_IN1, Q_PP1 = Q_OUT1 + I_SQ, Q_G1 = Q_PP1 + I_PP, Q_U1 = Q_G1 + I_MG, Q_D1 = Q_U1 + I_MG, Q_PG1 = Q_D1 + I_MD, Q_END = Q_PG1 + I_SQ;
__device__ __forceinline__ int q_deadline(int p) {
    switch (p) { case 0: return 0; case 1: case 2: return Q_OUT0; case 3: case 4: return Q_PP0; case 5: return Q_G0; case 6: return Q_D0; case 7: case 8: return Q_PG0; case 9: return Q_IN1;
                 case 10: case 11: return Q_OUT1; case 12: case 13: return Q_PP1; case 14: return Q_G1; case 15: return Q_D1; case 16: case 17: return Q_PG1; default: return Q_END; }
}
__device__ __forceinline__ TItem q_decode(Frame& F, int qi) {
    const int l = qi >= Q_IN1; const int r0 = qi - (l ? Q_IN1 : 0);
    const int iin = l ? I_IN1 : I_IN0;
    TItem d;
    if (r0 < iin) {
        if (!l) { const int kb = r0 / 80, nb = r0 % 80, c = nb * 32; const int dr = (c >= 1024 && c < 2048) ? head_perm(c) : c; d = TItem{IN(3), WSP(bf16, WS_WIN0), IN(2), EVEN_IN, kb * 64, c, 1024, dr}; }
        else { const int kb = r0 / 56, nb = r0 % 56, c = nb * 32; int dr;
            if (c < 768) dr = head_perm(c); else if (c < 1280) { const int cc = c - 768; dr = (3 + cc / 128) * 256 + (cc & 127); } else { const int cc = c - 1280; dr = (3 + cc / 128) * 256 + 128 + (cc & 127); }
            d = TItem{IN(12), WSP(bf16, WS_WIN1), IN(2) + 1024, ODD_IN, kb * 64, c, 1024, dr}; }
        return d; }
    int r = r0 - iin;
    if (r < I_SQ) { const int kb = r / 32, nb = r % 32; return TItem{l ? IN(19) : IN(11), WSP(bf16, l ? WS_WOUT1 : WS_WOUT0), nullptr, 1024, kb * 64, nb * 32, 1024, nb * 32}; }
    r -= I_SQ;
    if (r < I_PP) { const int kb = r / 32, nb = r % 32; return TItem{IN(28) + (size_t)l * 256 * 1024, WSP(bf16, WS_WPP) + (size_t)l * 1024 * 256, nullptr, 1024, kb * 64, nb * 32, 256, nb * 32}; }
    r -= I_PP;
    if (r < 2 * I_MG) { const int up = r >= I_MG; if (up) r -= I_MG; const int le = l * 32 + r / 128, q = r % 128, kb = q / 8, nb = q % 8, fc = nb * 32;
        return TItem{(up ? IN(26) : IN(25)) + (size_t)le * 1024 * 256, WSP(bf16, WS_W1) + (size_t)le * 512 * 1024, IN(20) + l * 1024, 256, kb * 64, fc, 1024, 256 * (fc >> 7) + 128 * up + (fc & 127)}; }
    r -= 2 * I_MG;
    if (r < I_MD) { const int le = l * 32 + r / 128, q = r % 128, kb = q / 32, nb = q % 32; return TItem{IN(27) + (size_t)le * 256 * 1024, WSP(bf16, WS_W2) + (size_t)le * 1024 * 256, nullptr, 1024, kb * 64, nb * 32, 256, nb * 32}; }
    r -= I_MD;
    { const int kb = r / 32, nb = r % 32; return TItem{IN(30) + (size_t)l * 1024 * 1024, WSP(bf16, WS_WPG) + (size_t)l * 1024 * 1024, IN(29) + l * 1024, 1024, kb * 64, nb * 32, 1024, nb * 32}; }
}
__device__ __forceinline__ void q_run(Frame& F, int lo, int hi, int widx, int wn) {
    LAS float* scr = (LAS float*)(F.lds + F.wave * 16384);
    const int lane = F.lane;
    int it = lo + widx; TItem da, db; float ra[32], rb[32];
    if (it < hi) { da = q_decode(F, it); titem_load(da, ra, lane); }
    while (it < hi) {
        int itn = it + wn;
        if (itn < hi) { db = q_decode(F, itn); titem_load(db, rb, lane); }
        titem_finish(da, ra, scr, lane, F.ws);
        it = itn; if (it >= hi) break;
        itn = it + wn;
        if (itn < hi) { da = q_decode(F, itn); titem_load(da, ra, lane); }
        titem_finish(db, rb, scr, lane, F.ws);
        it = itn;
    }
}
__device__ __forceinline__ void q_seam(Frame& F, int k, int idle_i, int idle_n) {
    constexpr int R1 = Q_OUT0 + 6144, R6 = Q_D0 + 7168, R10 = Q_U1 + 3072;
    static_assert(R1 < Q_D0 && R6 < Q_U1 && R10 < Q_D1, "conversion schedule");
    const int gw = F.vcu * NWAVES + F.wave, NGW = F.G * NWAVES;
    int lo = 0, hi = 0; bool idle_only = false;
    switch (k) { case 0: lo = 0; hi = Q_OUT0; break; case 1: lo = Q_OUT0; hi = R1; idle_only = true; break; case 5: lo = R1; hi = Q_D0; break; case 6: lo = Q_D0; hi = R6; idle_only = true; break;
                 case 7: lo = R6; hi = Q_U1; idle_only = true; break; case 10: lo = Q_U1; hi = R10; idle_only = true; break; case 14: lo = R10; hi = Q_D1; break; case 15: lo = Q_D1; hi = Q_END; idle_only = true; break; default: return; }
    int widx = gw, wn = NGW; bool mine = true;
    if (idle_only && idle_n > 0) { mine = idle_i >= 0; widx = idle_i * NWAVES + F.wave; wn = idle_n * NWAVES; }
    if (!mine) return;
    q_run(F, lo, hi, widx, wn);
}

__device__ __forceinline__ void p0_weights(Frame& F, int gw, int NGW) {
    const int lane = F.lane;
    { const size_t n4 = (size_t)2 * T * DPLE / 4; const GAS f32x4* src = (const GAS f32x4*)IN(1); GAS v2u* dst = (GAS v2u*)WSP(bf16, WS_PB);
      for (size_t i = (size_t)gw * 64 + lane; i < n4; i += (size_t)NGW * 64) { const f32x4 v = __builtin_nontemporal_load(src + i); v2u o; o.x = pk2(v.x, v.y); o.y = pk2(v.z, v.w); dst[i] = o; } }
    { bf16* RH = WSP(bf16, WS_RW); bf16* RL = RH + 2 * 48 * 1024;
      for (int i = gw * 64 + lane; i < 2 * 48 * 1024; i += NGW * 64) { const int l = i / (48 * 1024), n = (i / 1024) % 48, k = i % 1024; float v = 0.f;
          if (n < 4) v = IN(21)[((size_t)l * 1024 + k) * 4 + n]; else if (n < 36) { const int g = (n - 4) >> 3, j = (n - 4) & 7; v = IN(23)[(((size_t)l * 4 + g) * 1024 + k) * 8 + j]; }
          v *= IN(20)[l * 1024 + k];
          const unsigned h = pk2(v, 0.f) & 0xffffu; const float hf = __builtin_bit_cast(float, h << 16);
          RH[i] = (bf16)h; RL[i] = (bf16)(pk2(v - hf, 0.f) & 0xffffu); }
      float* RB = WSP(float, WS_RB);
      if (gw == 0) for (int i = lane; i < 96; i += 64) { const int l = i / 48, n = i % 48; RB[i] = n < 4 ? IN(22)[l * 4 + n] : (n < 36 ? IN(24)[l * 32 + n - 4] : 0.f); } }
    { bf16* GW = WSP(bf16, WS_GW);
      for (int i = gw * 64 + lane; i < 8 * 128 * 128 / 2; i += NGW * 64) { const int e = 2 * i, s = e & 127, t = (e >> 7) & 127; const float a = s <= t ? IN(7)[e] : 0.f, b = s + 1 <= t ? IN(7)[e + 1] : 0.f; ((unsigned*)GW)[i] = pk2(a, b); } }
    { float* RT = WSP(float, WS_ROPE);
      for (int i = gw * 64 + lane; i < 2048 * 8; i += NGW * 64) { const int pos = i >> 3, j = i & 7; const float inv = powf(500000.0f, -(float)j / 8.0f); const float ang = (float)pos * inv; RT[pos * 16 + j] = cosf(ang); RT[pos * 16 + 8 + j] = sinf(ang); } }
}
template <bool FLOG> __device__ __forceinline__ void p0_rows(Frame& F, const float* src, int layer) {
    const int lane = F.lane, r = lane & 15, q = lane >> 4, kh = F.wave >> 2, wp = F.wave & 3;
    LAS bf16* tH = (LAS bf16*)F.lds; LAS bf16* tL = tH + 8 * 1032; LAS float* rsl = (LAS float*)(F.lds + 40960) + F.wave * 16;
    LAS float* xch = (LAS float*)(F.lds + 49152) + wp * 512;
    __syncthreads();
    if (FLOG) {
        for (int idx = F.tid; idx < 8192; idx += NWAVES * 64) { const int n = idx & 7, k = idx >> 3; const float v = IN(3)[(size_t)k * EVEN_IN + 2560 + n] * IN(2)[k];
            const unsigned h = pk2(v, 0.f) & 0xffffu; tH[n * 1032 + k] = (bf16)h; tL[n * 1032 + k] = (bf16)(pk2(v - __builtin_bit_cast(float, h << 16), 0.f) & 0xffffu); }
        __syncthreads();
    }
    for (int task = F.vcu * 4 + wp; task < T / 16; task += F.G * 4) {
        const size_t row = (size_t)task * 16 + r;
        const float* xp = src + row * D + 512 * kh + 8 * q; bf16* hp = WSP(bf16, ws_hb(layer)) + row * D + 512 * kh + 8 * q;
        float ss = 0.f; f32x4 acc = {0.f, 0.f, 0.f, 0.f};
#pragma unroll 8
        for (int ks = 0; ks < 16; ++ks) {
            const f32x4 v0 = __builtin_nontemporal_load((const f32x4*)(xp + 32 * ks)), v1 = __builtin_nontemporal_load((const f32x4*)(xp + 32 * ks + 4));
            ss += (v0.x * v0.x + v0.y * v0.y) + (v0.z * v0.z + v0.w * v0.w) + (v1.x * v1.x + v1.y * v1.y) + (v1.z * v1.z + v1.w * v1.w);
            v4u o; o.x = pk2(v0.x, v0.y); o.y = pk2(v0.z, v0.w); o.z = pk2(v1.x, v1.y); o.w = pk2(v1.z, v1.w);
            wt16(ws_rsrc(F.ws), F.ws, hp + 32 * ks, o);
            if (FLOG) { bf16x8 bh = {0, 0, 0, 0, 0, 0, 0, 0}, bl = {0, 0, 0, 0, 0, 0, 0, 0};
                if (r < 8) { bh = *(const LAS bf16x8*)(tH + r * 1032 + 512 * kh + 32 * ks + 8 * q); bl = *(const LAS bf16x8*)(tL + r * 1032 + 512 * kh + 32 * ks + 8 * q); }
                const bf16x8 a = __builtin_bit_cast(bf16x8, o);
                acc = __builtin_amdgcn_mfma_f32_16x16x32_bf16(a, bh, acc, 0, 0, 0); acc = __builtin_amdgcn_mfma_f32_16x16x32_bf16(a, bl, acc, 0, 0, 0); }
        }
        *(f32x2*)(WSP(float, ws_ssq(layer)) + row * 16 + 4 * q + 2 * kh) = (f32x2){ss, 0.f};
        if (FLOG) {
            const float st = pg8::quad_sum(ss);
            if (kh == 1) { *(LAS f32x4*)(xch + lane * 8) = acc; xch[lane * 8 + 4] = st; }
            __syncthreads();
            if (kh == 0) {
                const f32x4 pa = *(const LAS f32x4*)(xch + lane * 8); const float ps = xch[lane * 8 + 4];
                acc = acc + pa;
                const float rs = rsqrtf((st + ps) * (1.f / D) + EPS);
                if (q == 0) rsl[r] = rs;
                LDS_WAIT(); asm volatile("" ::: "memory");
                const f32x4 r4 = *(const LAS f32x4*)(rsl + 4 * q);
                if (r < 8) { float* o = WSP(float, WS_CFL) + ((size_t)task * 16 + 4 * q) * 8 + r; o[0] = acc[0] * r4.x; o[8] = acc[1] * r4.y; o[16] = acc[2] * r4.z; o[24] = acc[3] * r4.w; }
            }
            __syncthreads();
        }
    }
}

template <bool FLOG> __device__ __forceinline__ void p0_rows4(Frame& F, const float* src, int layer, bool standalone) {
    const int lane = F.lane, r = lane & 15, q = lane >> 4;
    LAS bf16* tH = (LAS bf16*)F.lds; LAS bf16* tL = tH + 8 * 1032; LAS float* rsl = (LAS float*)(F.lds + 40960) + F.wave * 16;
    if (standalone) __syncthreads();
    if (FLOG && standalone) {
        for (int idx = F.tid; idx < 8192; idx += NWAVES * 64) { const int n = idx & 7, k = idx >> 3; const float v = IN(3)[(size_t)k * EVEN_IN + 2560 + n] * IN(2)[k];
            const unsigned h = pk2(v, 0.f) & 0xffffu; tH[n * 1032 + k] = (bf16)h; tL[n * 1032 + k] = (bf16)(pk2(v - __builtin_bit_cast(float, h << 16), 0.f) & 0xffffu); }
        __syncthreads();
    }
    if (F.wave < 4) {
        for (int task = F.vcu * 4 + F.wave; task < T / 16; task += F.G * 4) {
            const size_t row = (size_t)task * 16 + r;
            const float* xp = src + row * D + 8 * q; bf16* hp = WSP(bf16, ws_hb(layer)) + row * D + 8 * q;
            float ss = 0.f; f32x4 acc = {0.f, 0.f, 0.f, 0.f};
#pragma unroll 8
            for (int ks = 0; ks < 32; ++ks) {
                const f32x4 v0 = __builtin_nontemporal_load((const f32x4*)(xp + 32 * ks)), v1 = __builtin_nontemporal_load((const f32x4*)(xp + 32 * ks + 4));
                ss += (v0.x * v0.x + v0.y * v0.y) + (v0.z * v0.z + v0.w * v0.w) + (v1.x * v1.x + v1.y * v1.y) + (v1.z * v1.z + v1.w * v1.w);
                v4u o; o.x = pk2(v0.x, v0.y); o.y = pk2(v0.z, v0.w); o.z = pk2(v1.x, v1.y); o.w = pk2(v1.z, v1.w);
                wt16(ws_rsrc(F.ws), F.ws, hp + 32 * ks, o);
                if (FLOG) { bf16x8 bh = {0, 0, 0, 0, 0, 0, 0, 0}, bl = {0, 0, 0, 0, 0, 0, 0, 0};
                    if (r < 8) { bh = *(const LAS bf16x8*)(tH + r * 1032 + 32 * ks + 8 * q); bl = *(const LAS bf16x8*)(tL + r * 1032 + 32 * ks + 8 * q); }
                    const bf16x8 a = __builtin_bit_cast(bf16x8, o);
                    acc = __builtin_amdgcn_mfma_f32_16x16x32_bf16(a, bh, acc, 0, 0, 0); acc = __builtin_amdgcn_mfma_f32_16x16x32_bf16(a, bl, acc, 0, 0, 0); }
            }
            *(f32x4*)(WSP(float, ws_ssq(layer)) + row * 16 + 4 * q) = (f32x4){ss, 0.f, 0.f, 0.f};
            if (FLOG) {
                const float rs = rsqrtf(pg8::quad_sum(ss) * (1.f / D) + EPS);
                if (q == 0) rsl[r] = rs;
                LDS_WAIT(); asm volatile("" ::: "memory");
                const f32x4 r4 = *(const LAS f32x4*)(rsl + 4 * q);
                if (r < 8) { float* o = WSP(float, WS_CFL) + ((size_t)task * 16 + 4 * q) * 8 + r; o[0] = acc[0] * r4.x; o[8] = acc[1] * r4.y; o[16] = acc[2] * r4.z; o[24] = acc[3] * r4.w; }
                LDS_WAIT(); asm volatile("" ::: "memory");
            }
        }
    }
    if (FLOG && standalone) __syncthreads();
}

struct GmlpIn { v4u w0, w1; f32x4 gs[4]; v2u uw[4]; };
__device__ __forceinline__ void gmlp_load(Frame& F, int chunk, int g, GmlpIn& in, int tid, int tb, int db, int r32, int hi) {
    const int s = tid >> 2, cg = (tid & 3) * 16; const size_t tok = (size_t)chunk * 128 + s;
    const float* gsp = WSP(float, WS_GST) + tok * 16;
#pragma unroll
    for (int j = 0; j < 4; ++j) in.gs[j] = *(const f32x4*)(gsp + 4 * j);
    in.w0 = *(const v4u*)(WSP(bf16, WS_VG) + tok * 512 + g * 64 + cg); in.w1 = *(const v4u*)(WSP(bf16, WS_VG) + tok * 512 + g * 64 + cg + 8);
    const bf16* yp = WSP(bf16, WS_Y) + ((size_t)chunk * 128 + tb * 32 + r32) * 1024 + g * 64 + db * 32 + 4 * hi;
#pragma unroll
    for (int q = 0; q < 4; ++q) in.uw[q] = *(const v2u*)(yp + 8 * q);
}
__device__ __forceinline__ void gmlp_block(Frame& F, int layer) {
    const int tid = F.tid, lane = F.lane, wid = F.wave;
    LAS bf16* vnT = (LAS bf16*)F.lds;
    const int g = F.vcu & 7, db = wid & 1, tb = wid >> 1, r32 = lane & 31, hi = lane >> 5;
    const int nit = (1024 - F.vcu + F.G - 1) / F.G;
    if (nit <= 0) return;
    const bf16* Wg = WSP(bf16, WS_GW) + ((size_t)g * 128 + tb * 32 + r32) * 128 + hi * 8;
    bf16x8 bw[8];
#pragma unroll
    for (int ks = 0; ks < 8; ++ks) if (ks < 2 * (tb + 1)) bw[ks] = *(const bf16x8*)(Wg + ks * 16);
    const float bs = IN(8)[layer * 1024 + g * 128 + tb * 32 + r32];
    const int s = tid >> 2, cg = (tid & 3) * 16;
    float lg[16], lb[16];
    { const float* lgp = IN(5) + layer * 512 + g * 64 + cg; const float* lbp = IN(6) + layer * 512 + g * 64 + cg;
#pragma unroll
      for (int j = 0; j < 4; ++j) { const f32x4 a = *(const f32x4*)(lgp + 4 * j), b = *(const f32x4*)(lbp + 4 * j); lg[4 * j] = a.x; lg[4 * j + 1] = a.y; lg[4 * j + 2] = a.z; lg[4 * j + 3] = a.w; lb[4 * j] = b.x; lb[4 * j + 1] = b.y; lb[4 * j + 2] = b.z; lb[4 * j + 3] = b.w; } }
    GmlpIn cur, nxt;
    gmlp_load(F, (F.vcu >> 3), g, cur, tid, tb, db, r32, hi);
#pragma unroll 1
    for (int j = 0; j < nit; ++j) {
        const int chunk = (F.vcu + F.G * j) >> 3;
        if (j + 1 < nit) gmlp_load(F, (F.vcu + F.G * (j + 1)) >> 3, g, nxt, tid, tb, db, r32, hi);
        { float sm = 0.f, sq = 0.f;
#pragma unroll
          for (int q = 0; q < 4; ++q) { sm += cur.gs[q].x + cur.gs[q].z; sq += cur.gs[q].y + cur.gs[q].w; }
          const float mu = sm * (1.f / 512.f), var = sq * (1.f / 512.f) - mu * mu, rs = rsqrtf(var + EPS);
          const unsigned ww[8] = {cur.w0.x, cur.w0.y, cur.w0.z, cur.w0.w, cur.w1.x, cur.w1.y, cur.w1.z, cur.w1.w};
#pragma unroll
          for (int q = 0; q < 8; ++q) { const float a = (bf_lo(ww[q]) - mu) * rs * lg[2 * q] + lb[2 * q], b = (bf_hi(ww[q]) - mu) * rs * lg[2 * q + 1] + lb[2 * q + 1];
              const unsigned pk = pk2(a, b); vnT[(cg + 2 * q) * 136 + s] = (bf16)(pk & 0xffffu); vnT[(cg + 2 * q + 1) * 136 + s] = (bf16)(pk >> 16); } }
        __syncthreads();
        f32x16 acc = {};
#pragma unroll
        for (int ks = 0; ks < 8; ++ks) if (ks < 2 * (tb + 1)) {
            const bf16x8 a = *(const LAS bf16x8*)(vnT + (db * 32 + r32) * 136 + ks * 16 + hi * 8);
            acc = __builtin_amdgcn_mfma_f32_32x32x16_bf16(a, bw[ks], acc, 0, 0, 0);
        }
        bf16* yp = WSP(bf16, WS_Y) + ((size_t)chunk * 128 + tb * 32 + r32) * 1024 + g * 64 + db * 32 + 4 * hi;
#pragma unroll
        for (int q = 0; q < 4; ++q) {
            v2u o; o.x = pk2(bf_lo(cur.uw[q].x) * (acc[4 * q] + bs), bf_hi(cur.uw[q].x) * (acc[4 * q + 1] + bs)); o.y = pk2(bf_lo(cur.uw[q].y) * (acc[4 * q + 2] + bs), bf_hi(cur.uw[q].y) * (acc[4 * q + 3] + bs));
            wt8(ws_rsrc(F.ws), F.ws, yp + 8 * q, o); }
        __syncthreads();
        cur = nxt;
    }
}

__device__ __forceinline__ void conv_load(Frame& F, int item, v4u (&hv)[8], int wid, int lane) {
    const int t0 = item * 32, pos0 = t0 & (SEQ - 1);
#pragma unroll
    for (int i = 0; i < 8; ++i) { const int r = wid + 8 * i; const int p = pos0 - 30 + r; hv[i] = (v4u){0u, 0u, 0u, 0u};
        if (r < 62 && p >= 0) hv[i] = *(const v4u*)(WSP(bf16, WS_VG) + (size_t)(t0 - 30 + r) * 512 + lane * 8); }
}
__device__ __forceinline__ void conv_block(Frame& F) {
    const int tid = F.tid, lane = F.lane, wid = F.wave;
    LAS bf16* hs = (LAS bf16*)F.lds;
    LAS float* cs = (LAS float*)(F.lds + 65536);
    const int nit = (512 - F.vcu + F.G - 1) / F.G;
    if (nit <= 0) return;
    float w[31];
#pragma unroll
    for (int k = 0; k < 31; ++k) w[k] = IN(16)[k * 512 + tid];
    const f32x4 g0 = *(const f32x4*)(IN(17) + lane * 8), g1 = *(const f32x4*)(IN(17) + lane * 8 + 4), b0 = *(const f32x4*)(IN(18) + lane * 8), b1 = *(const f32x4*)(IN(18) + lane * 8 + 4);
    v4u hv[8], hn[8];
    conv_load(F, F.vcu, hv, wid, lane);
#pragma unroll 1
    for (int j = 0; j < nit; ++j) {
        const int t0 = (F.vcu + F.G * j) * 32;
#pragma unroll
        for (int i = 0; i < 8; ++i) { const int r = wid + 8 * i; if (r < 62) *(LAS v4u*)(hs + r * 512 + lane * 8) = hv[i]; }
        if (j + 1 < nit) conv_load(F, F.vcu + F.G * (j + 1), hn, wid, lane);
        __syncthreads();
        float win[62];
#pragma unroll
        for (int r = 0; r < 62; ++r) win[r] = __builtin_bit_cast(float, (unsigned)hs[r * 512 + tid] << 16);
#pragma unroll
        for (int tt = 0; tt < 32; ++tt) { float a = 0.f;
#pragma unroll
            for (int k = 0; k < 31; ++k) a += w[k] * win[tt + k];
            cs[tt * 512 + tid] = a; }
        __syncthreads();
#pragma unroll
        for (int q = 0; q < 4; ++q) { const int tt = wid * 4 + q;
            const f32x4 a = *(const LAS f32x4*)(cs + tt * 512 + lane * 8), b = *(const LAS f32x4*)(cs + tt * 512 + lane * 8 + 4);
            const float mu = wave_sum((a.x + a.y) + (a.z + a.w) + (b.x + b.y) + (b.z + b.w)) * (1.f / 512.f);
            const f32x4 da = a - mu, db = b - mu;
            const float var = wave_sum((da.x * da.x + da.y * da.y) + (da.z * da.z + da.w * da.w) + (db.x * db.x + db.y * db.y) + (db.z * db.z + db.w * db.w)) * (1.f / 512.f);
            const float rs = rsqrtf(var + EPS);
            f32x4 y0 = da * rs * g0 + b0, y1 = db * rs * g1 + b1;
#pragma unroll
            for (int i = 0; i < 4; ++i) { y0[i] = pg8::fast_silu(y0[i]); y1[i] = pg8::fast_silu(y1[i]); }
            pg8::store8(ws_rsrc(F.ws), F.ws, WSP(bf16, WS_Y) + (size_t)(t0 + tt) * 1024 + 512 + lane * 8, y0, y1); }
        __syncthreads();
#pragma unroll
        for (int i = 0; i < 8; ++i) hv[i] = hn[i];
    }
}

__device__ __forceinline__ void router_phase(Frame& F, int layer) {
    const int lane = F.lane, wid = F.wave, tid = F.tid;
    LAS float* part = (LAS float*)F.lds;
    LAS float* lg = (LAS float*)(F.lds + 98304);
    const bf16* RH = WSP(bf16, WS_RW) + (size_t)layer * 48 * 1024; const bf16* RL = RH + 2 * 48 * 1024; const float* RB = WSP(float, WS_RB) + layer * 48;
    const int fr = lane & 15, fq = lane >> 4;
    for (int blk = F.vcu; blk < T / 64; blk += F.G) {
        bf16x8 a[4][4], bh[3][4], bl[3][4];
#pragma unroll
        for (int t = 0; t < 4; ++t)
#pragma unroll
            for (int ks = 0; ks < 4; ++ks) a[t][ks] = *(const bf16x8*)(WSP(bf16, ws_hb(layer)) + (size_t)(blk * 64 + t * 16 + fr) * D + 128 * wid + 32 * ks + 8 * fq);
#pragma unroll
        for (int f = 0; f < 3; ++f)
#pragma unroll
            for (int ks = 0; ks < 4; ++ks) { const size_t o = (size_t)(fr + 16 * f) * 1024 + 128 * wid + 32 * ks + 8 * fq; bh[f][ks] = *(const bf16x8*)(RH + o); bl[f][ks] = *(const bf16x8*)(RL + o); }
#pragma unroll
        for (int t = 0; t < 4; ++t) {
            f32x4 acc[3] = {{0.f, 0.f, 0.f, 0.f}, {0.f, 0.f, 0.f, 0.f}, {0.f, 0.f, 0.f, 0.f}};
#pragma unroll
            for (int ks = 0; ks < 4; ++ks)
#pragma unroll
                for (int f = 0; f < 3; ++f) { acc[f] = __builtin_amdgcn_mfma_f32_16x16x32_bf16(a[t][ks], bh[f][ks], acc[f], 0, 0, 0); acc[f] = __builtin_amdgcn_mfma_f32_16x16x32_bf16(a[t][ks], bl[f][ks], acc[f], 0, 0, 0); }
#pragma unroll
            for (int f = 0; f < 3; ++f)
#pragma unroll
                for (int r = 0; r < 4; ++r) part[wid * 3072 + (t * 16 + 4 * fq + r) * 48 + 16 * f + fr] = acc[f][r];
        }
        __syncthreads();
        for (int i = tid; i < 3072; i += NWAVES * 64) { float s = 0.f;
#pragma unroll
            for (int w = 0; w < 8; ++w) s += part[w * 3072 + i];
            lg[i] = s; }
        __syncthreads();
        if (wid == 0) {
            const int tok = blk * 64 + lane;
            const float* sp = WSP(float, ws_ssq(layer)) + (size_t)tok * 16; float ss = 0.f;
#pragma unroll
            for (int j = 0; j < 4; ++j) { const f32x4 p = *(const f32x4*)(sp + 4 * j); ss += (p.x + p.y) + (p.z + p.w); }
            const float rs = rsqrtf(ss * (1.f / D) + EPS);
            float pc[4];
#pragma unroll
            for (int j = 0; j < 4; ++j) pc[j] = lg[lane * 48 + j] * rs + RB[j];
            int g = 0; float cm = pc[0];
#pragma unroll
            for (int j = 1; j < 4; ++j) if (pc[j] > cm) { cm = pc[j]; g = j; }
            float den = 0.f;
#pragma unroll
            for (int j = 0; j < 4; ++j) den += __expf(pc[j] - cm);
            const float pg = 1.f / den;
            float fv[8];
#pragma unroll
            for (int j = 0; j < 8; ++j) fv[j] = lg[lane * 48 + 4 + g * 8 + j] * rs + RB[4 + g * 8 + j];
            int i0 = 0; float v0 = fv[0];
#pragma unroll
            for (int j = 1; j < 8; ++j) if (fv[j] > v0) { v0 = fv[j]; i0 = j; }
            int i1 = -1; float v1 = -INFINITY;
#pragma unroll
            for (int j = 0; j < 8; ++j) if (j != i0 && (i1 < 0 || fv[j] > v1)) { v1 = fv[j]; i1 = j; }
            const float e1 = __expf(v1 - v0);
            const float p0 = pg / (1.f + e1), p1 = pg * e1 / (1.f + e1);
            const int e0 = g * 8 + i0, e1i = g * 8 + i1;
            int r0 = 0, r1 = 0, mycnt = 0;
            const unsigned long long lt = (1ull << lane) - 1ull;
#pragma unroll 1
            for (int e = 0; e < NE; ++e) {
                const unsigned long long m0 = __ballot(e0 == e), m1 = __ballot(e1i == e);
                const int below = __popcll(m0 & lt) + __popcll(m1 & lt);
                if (e0 == e) r0 = below; if (e1i == e) r1 = below;
                if (lane == e) mycnt = __popcll(m0) + __popcll(m1);
            }
            int* eid = WSP(int, WS_EID); float* ew = WSP(float, WS_EW); int* lr = WSP(int, WS_LRANK);
            eid[tok * 2] = e0; eid[tok * 2 + 1] = e1i; ew[tok * 2] = p0; ew[tok * 2 + 1] = p1; lr[tok * 2] = r0; lr[tok * 2 + 1] = r1;
            if (lane < NE) WSP(int, WS_BCNT)[blk * NE + lane] = mycnt;
        }
        __syncthreads();
    }
}

__device__ __forceinline__ void moe_segments(Frame& F, LAS int* seg, LAS int* scr, int myblk) {
    const int tid = F.tid, e = tid & 31, part = tid >> 5;
    const int* bc = WSP(int, WS_BCNT);
    int s = 0, sb = 0;
#pragma unroll 4
    for (int i = 0; i < 16; ++i) { const int b = part * 16 + i; const int c = bc[b * NE + e]; s += c; if (b < myblk) sb += c; }
    scr[part * 32 + e] = s; scr[512 + part * 32 + e] = sb;
    __syncthreads();
    if (tid < 32) { int tot = 0, base = 0;
#pragma unroll
        for (int p = 0; p < 16; ++p) { tot += scr[p * 32 + tid]; base += scr[512 + p * 32 + tid]; }
        seg[64 + tid] = base; seg[128 + tid] = tot; scr[tid] = (tot + 255) & ~255; }
    __syncthreads();
    if (tid == 0) { int off = 0; for (int k = 0; k < NE; ++k) { seg[k] = off; off += scr[k]; } seg[NE] = off; }
    __syncthreads();
    if (tid < ROWS_MAX / 256) { int e = 0;
#pragma unroll 1
        for (int k = 1; k < NE; ++k) if ((seg[k] >> 8) <= tid) e = k;
        seg[192 + tid] = e; }
    __syncthreads();
}
__device__ __forceinline__ void dispatch_phase(Frame& F, int layer) {
    LAS int* seg = (LAS int*)(F.lds + MISC_OFF + 1024); LAS int* scr = (LAS int*)F.lds;
    const int lane = F.lane, wid = F.wave;
    const int* eid = WSP(int, WS_EID); const float* ew = WSP(float, WS_EW); const int* lr = WSP(int, WS_LRANK); int* tokpos = WSP(int, WS_TOKPOS); float* roww = WSP(float, WS_ROWW); float* rowrs = WSP(float, WS_ROWRS);
    for (int blk = F.vcu; blk < T / 64; blk += F.G) {
        moe_segments(F, seg, scr, blk);
        if (blk < NE) { const int b = seg[blk] + seg[128 + blk], en = seg[blk + 1];
            for (int r = b + F.tid; r < en; r += NWAVES * 64) { roww[r] = 0.f; rowrs[r] = 0.f; WSP(int, WS_ROWTOK)[r] = 0; } }
        const int base = blk * 64 + wid * 8;
        int pos = 0;
        if (lane < 16) { const int tok = base + (lane >> 1), j = lane & 1; const int e = eid[tok * 2 + j];
            pos = seg[e] + seg[64 + e] + lr[tok * 2 + j];
            const float* sp = WSP(float, ws_ssq(layer)) + (size_t)tok * 16; float ss = 0.f;
#pragma unroll
            for (int q = 0; q < 4; ++q) { const f32x4 p = *(const f32x4*)(sp + 4 * q); ss += (p.x + p.y) + (p.z + p.w); }
            roww[pos] = ew[tok * 2 + j]; rowrs[pos] = rsqrtf(ss * (1.f / D) + EPS); tokpos[tok * 2 + j] = pos; WSP(int, WS_ROWTOK)[pos] = tok; }
        __syncthreads();
    }
}
template <int NT, int BPE> struct GroupedOrder {
    const LAS int* seg; int G, c;
    __device__ __forceinline__ bool next(int i, pg8::Unit& u) const {
        const int L = i * G + c; const int total = (seg[NE] >> 8) * NT; if (L >= total) return false;
        const int mt = L / NT, nt = L % NT; const int e = seg[192 + mt];
        u.pm = mt; u.pn = e * BPE + nt; u.pc = nt; return true;
    }
    __device__ __forceinline__ void a_ready(const pg8::Unit&) const {}
    __device__ __forceinline__ void done(const pg8::Unit&) const {}
};
__device__ __forceinline__ void combine_phase(Frame& F, int layer) {
    const int lane = F.lane, gw = F.vcu * NWAVES + F.wave, NGW = F.G * NWAVES;
    const int* tokpos = WSP(int, WS_TOKPOS);
    for (int m = gw; m < T; m += NGW) {
        const int p0 = tokpos[m * 2], p1 = tokpos[m * 2 + 1];
        GAS v4u* hr = (GAS v4u*)(WSP(bf16, ws_hb(layer)) + (size_t)m * D) + 2 * lane;
        const GAS v4u* a = (const GAS v4u*)(WSP(bf16, WS_MG) + (size_t)p0 * D) + 2 * lane; const GAS v4u* b = (const GAS v4u*)(WSP(bf16, WS_MG) + (size_t)p1 * D) + 2 * lane;
        const v4u h0 = hr[0], h1 = hr[1], a0 = __builtin_nontemporal_load(a), a1 = __builtin_nontemporal_load(a + 1), b0 = __builtin_nontemporal_load(b), b1 = __builtin_nontemporal_load(b + 1);
        const unsigned hw[8] = {h0.x, h0.y, h0.z, h0.w, h1.x, h1.y, h1.z, h1.w}, aw[8] = {a0.x, a0.y, a0.z, a0.w, a1.x, a1.y, a1.z, a1.w}, bw[8] = {b0.x, b0.y, b0.z, b0.w, b1.x, b1.y, b1.z, b1.w};
        unsigned ow[8]; float s = 0.f;
#pragma unroll
        for (int j = 0; j < 8; ++j) { const float lo = bf_lo(hw[j]) + bf_lo(aw[j]) + bf_lo(bw[j]), hi = bf_hi(hw[j]) + bf_hi(aw[j]) + bf_hi(bw[j]); ow[j] = pk2(lo, hi); s += lo * lo + hi * hi; }
        wt16(ws_rsrc(F.ws), F.ws, (const void*)hr, (v4u){ow[0], ow[1], ow[2], ow[3]}); wt16(ws_rsrc(F.ws), F.ws, (const void*)(hr + 1), (v4u){ow[4], ow[5], ow[6], ow[7]});
        s += xor_lane<1>(s); s += xor_lane<2>(s);
        if ((lane & 3) == 0) WSP(float, ws_ssq(layer))[(size_t)m * 16 + (lane >> 2)] = s;
    }
}

#ifndef MK_SP2K
#define MK_SP2K true
#endif
constexpr int N_PHASES = 19;
__global__ void __launch_bounds__(NWAVES * 64, 2) mega(Args args) {
    extern __shared__ __attribute__((aligned(16))) unsigned char lds[];
    Frame F;
    F.lds = (LAS unsigned char*)lds; F.ws = args.ws; F.ctl = (gu32*)(args.ws + WS_CTL); F.out = (args.flags & 32) ? (float*)(args.ws + WS_HB) : args.out;
    F.tid = threadIdx.x; F.lane = F.tid & 63; F.wave = __builtin_amdgcn_readfirstlane(F.tid >> 6);
    F.G = gridDim.x; { const int bx = blockIdx.x; F.vcu = (F.G % 8 == 0) ? (bx % 8) * (F.G / 8) + bx / 8 : bx; }
    volatile LAS unsigned* MISC = (volatile LAS unsigned*)(F.lds + MISC_OFF);
    for (int u = F.tid; u < 64; u += NWAVES * 64) MISC[u] = 0u;
    __syncthreads();
    XcdBarrier bar = xcd_barrier_post((unsigned*)(F.ctl + CW_BAR) + args.li * XCD_BAR_WORDS, MISC + 8);
    const int lo = args.ph_lo, hi = args.ph_hi;
#ifndef MK_QX
#define MK_QX 1
#endif
    int idle_i = -1, idle_n = 0;
#ifndef MK_ONLY
#define MK_ONLY -1
#endif
#define PH(k) ((MK_ONLY < 0 || MK_ONLY == ((k) == 0 ? 0 : 1 + ((k) - 1) % 9)) && lo <= (k) && (k) < hi)
#define SEAM(k) do { if (PH(k) && PH((k) + 1)) { __syncthreads(); if (!(args.flags & 64)) q_seam(F, (k), idle_i, idle_n); xcd_barrier(bar); } idle_i = -1; idle_n = 0; OPAQ(); } while (0)
#define OPAQ() do { asm volatile("" : "+s"(F.wave), "+s"(F.vcu)); F.lane = lane_id(); asm volatile("" : "+v"(F.lane)); F.tid = F.wave * 64 + F.lane; } while (0)
    if (PH(0)) {
        if ((args.flags & 7) == 3) {
            { LAS bf16* tH = (LAS bf16*)F.lds; LAS bf16* tL = tH + 8 * 1032;
              for (int idx = F.tid; idx < 8192; idx += NWAVES * 64) { const int n = idx & 7, k = idx >> 3; const float v = IN(3)[(size_t)k * EVEN_IN + 2560 + n] * IN(2)[k];
                  const unsigned h = pk2(v, 0.f) & 0xffffu; tH[n * 1032 + k] = (bf16)h; tL[n * 1032 + k] = (bf16)(pk2(v - __builtin_bit_cast(float, h << 16), 0.f) & 0xffffu); } }
            __syncthreads();
            if (F.wave < 4) p0_rows4<true>(F, args.prep_src, args.prep_layer, false);
            else p0_weights(F, F.vcu * 4 + F.wave - 4, F.G * 4);
        } else {
            if (args.flags & 1) p0_weights(F, F.vcu * NWAVES + F.wave, F.G * NWAVES);
            if (args.flags & 2) p0_rows<true>(F, args.prep_src, args.prep_layer);
            if (args.flags & 4) p0_rows<false>(F, args.prep_src, args.prep_layer);
        }
    }
    SEAM(0);
#pragma unroll 1
    for (int layer = 0; layer < 2; ++layer) {
        const int pb = 1 + 9 * layer;
        if (PH(pb + 0)) {
#ifndef MK_K0
#define MK_K0 7
#endif
            if (args.flags & 8) {} else if (layer == 0 && (MK_K0 & 1)) {
                pg8::Gemm g{WSP(bf16, ws_hb(0)), WSP(bf16, WS_WIN0), T, N_IN0, D}; pg8::StaticOrder S; S.init(T, N_IN0, F.G, (int)blockIdx.x);
                pg8::EpIn0 E{F.ws};
                pg8::gemm_phase<pg8::EpIn0, pg8::StaticOrder, true, true>(F.lds, g, S, E, F.wave);
                idle_n = 128; idle_i = (int)blockIdx.x - 128;
            } else if (MK_K0 & 2) {
                pg8::Gemm g{WSP(bf16, ws_hb(1)), WSP(bf16, WS_WIN1), T, N_IN1, D}; pg8::StaticOrder S; S.init(T, N_IN1, F.G, (int)blockIdx.x);
                pg8::EpIn1 E{F.ws};
                pg8::gemm_phase<pg8::EpIn1, pg8::StaticOrder, true, true>(F.lds, g, S, E, F.wave);
                idle_n = 64; idle_i = (int)blockIdx.x - 192;
            }
        }
        SEAM(pb + 0);
        if (PH(pb + 1)) {
            if (layer == 0) {
                const int bh = F.vcu >> 2, s = F.vcu & 3, b = bh >> 3, h = bh & 7;
#ifndef MK_MIX
#define MK_MIX 15
#endif
                if (bh < 64 && (MK_MIX & 1) && !(args.flags & 256)) {
                    attn_body::fox_scan(b, h, WSP(float, WS_CFL), IN(4)[h], (char*)lds, F.wave);
                    const attn_body::bf16* Yq = (const attn_body::bf16*)(WSP(bf16, WS_Y) + 512);
                    attn_body::fox_unit<8, 1024, 512>(b, h, s, Yq, (const attn_body::bf16*)WSP(bf16, WS_KB), (const attn_body::bf16*)WSP(bf16, WS_VB), (attn_body::bf16*)(WSP(bf16, WS_Y) + 512), (char*)lds, F.wave, F.ws);
                    attn_body::fox_unit<8, 1024, 512>(b, h, 7 - s, Yq, (const attn_body::bf16*)WSP(bf16, WS_KB), (const attn_body::bf16*)WSP(bf16, WS_VB), (attn_body::bf16*)(WSP(bf16, WS_Y) + 512), (char*)lds, F.wave, F.ws);
                }
                __syncthreads();
                if ((MK_MIX & 2) && !(args.flags & 512)) gmlp_block(F, 0);
            } else {
                if ((MK_MIX & 4) && !(args.flags & 256)) for (int it = F.vcu; it < 512; it += F.G) {
                    const int qb = it & 31, kvh = (it >> 5) & 1, b = it >> 6;
                    attn_body::swa_unit<1024, 128>(b, kvh, qb, (const attn_body::bf16*)WSP(bf16, WS_Y), (const attn_body::bf16*)WSP(bf16, WS_KB), (const attn_body::bf16*)WSP(bf16, WS_VB), (attn_body::bf16*)WSP(bf16, WS_Y), IN(15), (char*)lds, F.wave, F.ws);
                }
                __syncthreads();
                if ((MK_MIX & 8) && !(args.flags & 512)) conv_block(F);
            }
        }
        SEAM(pb + 1);
        if (PH(pb + 2)) {
            pg8::Gemm g{WSP(bf16, WS_Y), WSP(bf16, layer ? WS_WOUT1 : WS_WOUT0), T, D, D}; pg8::StaticOrder S; S.init(T, D, F.G, (int)blockIdx.x);
            pg8::EpRes<false> E{F.out, F.ws, layer};
            pg8::gemm_phase<pg8::EpRes<false>, pg8::StaticOrder, true, true>(F.lds, g, S, E, F.wave);
        }
        SEAM(pb + 2);
        if (PH(pb + 3)) router_phase(F, layer);
        SEAM(pb + 3);
        if (PH(pb + 4)) {
            if (!(args.flags & 16)) dispatch_phase(F, layer);
        }
        SEAM(pb + 4);
        if (PH(pb + 5)) {
            LAS int* seg = (LAS int*)(F.lds + MISC_OFF + 1024); moe_segments(F, seg, (LAS int*)F.lds, 0);
            pg8::Gemm g{WSP(bf16, ws_hb(layer)), WSP(bf16, WS_W1) + (size_t)layer * NE * 512 * 1024, ROWS_MAX, 512, D};
            GroupedOrder<2, 2> S{seg, F.G, F.vcu};
            pg8::EpMoe1 E{F.ws};
            pg8::gemm_phase<pg8::EpMoe1, GroupedOrder<2, 2>, true, true, true>(F.lds, g, S, E, F.wave, WSP(int, WS_ROWTOK));
            { const int tot = (seg[NE] >> 8) * 2, rounds = (tot + F.G - 1) / F.G, first = tot - (rounds - 1) * F.G; idle_n = F.G - first; idle_i = F.vcu - first; }
            if (idle_n <= 0 || idle_i >= 0) { pg8::Gemm g{WSP(bf16, WS_PB) + (size_t)layer * T * DPLE, WSP(bf16, WS_WPP) + (size_t)layer * 1024 * 256, T, D, DPLE}; pg8::StaticOrder S; S.init(T, D, idle_n > 0 ? idle_n : F.G, idle_n > 0 ? idle_i : F.vcu);
              pg8::EpBf16 E{WSP(bf16, WS_PP), 1024, F.ws};
              pg8::gemm_phase<pg8::EpBf16, pg8::StaticOrder, true, MK_SP2K>(F.lds, g, S, E, F.wave); }

        }
        SEAM(pb + 5);
        if (PH(pb + 6)) {
            LAS int* seg = (LAS int*)(F.lds + MISC_OFF + 1024); moe_segments(F, seg, (LAS int*)F.lds, 0);
            pg8::Gemm g{WSP(bf16, WS_HID), WSP(bf16, WS_W2) + (size_t)layer * NE * 1024 * 256, ROWS_MAX, 1024, DEXP};
            GroupedOrder<4, 4> S{seg, F.G, F.vcu};
            pg8::EpBf16 E{WSP(bf16, WS_MG), (args.flags & 1024) ? -1 : 1024, F.ws};
            pg8::gemm_phase<pg8::EpBf16, GroupedOrder<4, 4>, true, MK_SP2K>(F.lds, g, S, E, F.wave);
            { const int tot = (seg[NE] >> 8) * 4, rounds = (tot + F.G - 1) / F.G, first = tot - (rounds - 1) * F.G; idle_n = F.G - first; idle_i = F.vcu - first; }
        }
        SEAM(pb + 6);
        if (PH(pb + 7)) combine_phase(F, layer);
        SEAM(pb + 7);
        if (PH(pb + 8)) {
            pg8::Gemm g{WSP(bf16, ws_hb(layer)), WSP(bf16, WS_WPG) + (size_t)layer * 1024 * 1024, T, D, D}; pg8::StaticOrder S; S.init(T, D, F.G, (int)blockIdx.x);
            pg8::EpRes<true> E{F.out, F.ws, layer};
            pg8::gemm_phase<pg8::EpRes<true>, pg8::StaticOrder, true, true>(F.lds, g, S, E, F.wave);
        }
        SEAM(pb + 8);
    }
#undef PH
#undef SEAM
}
}

#ifndef MK_CFG
#define MK_CFG 0
#endif
static void naive_mix(int layer, void* const* d_in, float* h, char* ws, hipStream_t stream);
static void naive_moe(int layer, void* const* d_in, float* h, char* ws, hipStream_t stream);
static void naive_ple(int layer, void* const* d_in, float* h, char* ws, hipStream_t stream);

extern "C" void kernel_launch(void* const* d_in, const int* in_sizes, int n_in, void* d_out, int out_size, void* d_ws, size_t ws_size, hipStream_t stream) {
    using namespace mk;
    static int grid = 0;
    if (grid == 0) {
        if (n_in != 31 || out_size != T * D || ws_size < WS_END) { fprintf(stderr, "kernel_launch: unexpected shapes (n_in %d out %d ws %zu, need %zu)\n", n_in, out_size, ws_size, (size_t)WS_END); grid = -1; return; }
        int dev = 0, cus = 0, per_cu = 0;
        if (hipGetDevice(&dev) != hipSuccess || hipDeviceGetAttribute(&cus, hipDeviceAttributeMultiprocessorCount, dev) != hipSuccess) { grid = -1; return; }
        if (hipFuncSetAttribute((const void*)mega, hipFuncAttributeMaxDynamicSharedMemorySize, LDS_BYTES) != hipSuccess) { fprintf(stderr, "kernel_launch: hipFuncSetAttribute failed\n"); grid = -1; return; }
        if (hipOccupancyMaxActiveBlocksPerMultiprocessor(&per_cu, (const void*)mega, NWAVES * 64, LDS_BYTES) != hipSuccess || per_cu < 1) { fprintf(stderr, "kernel_launch: occupancy query says %d\n", per_cu); per_cu = 1; }
        (void)hipGetLastError();
        grid = cus;
        if (grid != 256) { fprintf(stderr, "kernel_launch: built for 256 CUs, got %d\n", grid); grid = -1; return; }
    }
    if (grid < 0) return;
    (void)hipMemsetAsync((char*)d_ws + WS_CTL, 0, CTL_ZERO_BYTES, stream);
    Args a{};
    for (int i = 0; i < 31; ++i) a.in[i] = (const float*)d_in[i];
    a.out = (float*)d_out; a.ws = (unsigned char*)d_ws;
    int li = 0;
    auto launch = [&](int lo, int hi, int flags, const float* prep_src, int prep_layer) {
        a.ph_lo = lo; a.ph_hi = hi; a.flags = flags; a.prep_src = prep_src; a.prep_layer = prep_layer; a.li = li++;
        hipLaunchKernelGGL(mega, dim3(grid), dim3(NWAVES * 64), LDS_BYTES, stream, a);
    };
#if MK_CFG == 0
    launch(0, N_PHASES, 1 | 2, (const float*)d_in[0], 0);
#elif MK_CFG == 2
    launch(0, N_PHASES, 1 | 2, (const float*)d_in[0], 0);
    for (int r = 0; r < MK_REP; ++r) { (void)hipMemsetAsync((char*)d_ws + WS_CTL, 0, 16384, stream); launch(MK_PLO, MK_PHI, 32 | 64 | (MK_PLO == 0 ? MK_PFLAGS : (MK_PFLAGS & ~3)), (const float*)d_in[0], 0); }
#elif MK_CFG == 1
    launch(0, 1, 1 | 2, (const float*)d_in[0], 0);
    for (int p = 1; p < N_PHASES; ++p) launch(p, p + 1, 0, nullptr, 0);
#else
    {
        const int bits = MK_CFG - 100; float* h = (float*)d_out; char* ws = (char*)d_ws;
        (void)hipMemcpyAsync(h, d_in[0], (size_t)T * D * 4, hipMemcpyDeviceToDevice, stream);
        for (int layer = 0; layer < 2; ++layer) {
            const int pb = 1 + 9 * layer;
            if (bits & (1 << (3 * layer + 0))) { launch(0, 1, 1, nullptr, 0); launch(0, 1, layer == 0 ? 2 : 4, h, layer); for (int p = pb; p < pb + 3; ++p) launch(p, p + 1, 0, nullptr, 0); }
            else naive_mix(layer, d_in, h, ws, stream);
            if (bits & (1 << (3 * layer + 1))) { (void)hipMemsetAsync((char*)d_ws + WS_CTL, 0, 4096, stream); launch(0, 1, 1, nullptr, 0); launch(0, 1, 4, h, layer); for (int p = pb + 3; p < pb + 8; ++p) launch(p, p + 1, 0, nullptr, 0); }
            else naive_moe(layer, d_in, h, ws, stream);
            if (bits & (1 << (3 * layer + 2))) { launch(0, 1, 1, nullptr, 0); launch(0, 1, 4, h, layer); launch(pb + 4, pb + 5, 16, nullptr, 0); launch(pb + 8, pb + 9, 0, nullptr, 0); }
            else naive_ple(layer, d_in, h, ws, stream);
        }
    }
#endif
}
```
